# Optimizing an MI355X kernel written in HIP

```python
import math
import jax, jax.numpy as jnp
from jax import lax
import numpy as np

D_MODEL = 2048
BATCH = 1
SEQ = 16384
DEPTH = 1

CHUNK = 64
Q_BLOCK = 128
EPS = 1e-6
ROPE_THETA = 10000.0

M_HEADS = 4
M_DV = D_MODEL // 2 // M_HEADS
M_DQK = M_DV // 2
M_CONV = 4
GATE_CAP = 15.0
M_WIDTH = M_HEADS * M_DV

A_HEADS = 8
A_DH = D_MODEL // 2 // A_HEADS // 2
A_DV = 2 * A_DH
A_WIDTH = A_HEADS * A_DV

D_FF = -(-8 * D_MODEL // (3 * 256)) * 256

N_MQK = M_HEADS * M_DQK
IN_SIZES = (N_MQK, N_MQK, M_WIDTH, M_WIDTH, M_HEADS, M_HEADS,
            2 * A_HEADS * A_DH, 2 * A_HEADS * A_DH, A_WIDTH)
N_IN = sum(IN_SIZES)

kernel_name = "hybrid_mlstm_diffattn_block"


def rmsnorm(x, g):
    x32 = x.astype(jnp.float32)
    y = x32 * lax.rsqrt(jnp.mean(x32 * x32, axis=-1, keepdims=True) + EPS)
    return (y * g.astype(jnp.float32)).astype(x.dtype)


def split_proj(p):
    idx = np.cumsum(np.array(IN_SIZES))[:-1].tolist()
    return jnp.split(p, idx, axis=-1)


def rope(t, pos):
    half = t.shape[-1] // 2
    inv = ROPE_THETA ** (-jnp.arange(half, dtype=jnp.float32) / half)
    ang = pos.astype(jnp.float32)[:, None] * inv[None, :]
    cos = jnp.cos(ang).astype(t.dtype)
    sin = jnp.sin(ang).astype(t.dtype)
    t1, t2 = t[..., :half], t[..., half:]
    return jnp.concatenate([t1 * cos - t2 * sin, t2 * cos + t1 * sin], axis=-1)


def causal_conv(x, w, b):
    K = w.shape[0]
    S = x.shape[1]
    xp = jnp.pad(x, ((0, 0), (K - 1, 0), (0, 0)))
    y = b
    for j in range(K):
        y = y + xp[:, j:j + S] * w[j]
    return y


def mlstm_chunkwise(q, k, v, i_pre, f_pre):
    B, H, S, Dqk = q.shape
    Dv = v.shape[-1]
    NC = S // CHUNK
    q = q.astype(jnp.float32) * (Dqk ** -0.5)
    k = k.astype(jnp.float32)
    v = v.astype(jnp.float32)
    logf = jax.nn.log_sigmoid(f_pre.astype(jnp.float32))
    logi = i_pre.astype(jnp.float32)

    def to_chunks(t):
        return jnp.moveaxis(t.reshape((B, H, NC, CHUNK) + t.shape[3:]), 2, 0)

    qc, kc, vc, ic, fc = map(to_chunks, (q, k, v, logi, logf))
    causal = jnp.tril(jnp.ones((CHUNK, CHUNK), dtype=bool))

    def step(carry, xs):
        C, n, m = carry
        qb, kb, vb, ib, fb = xs
        b = jnp.cumsum(fb, axis=-1)
        logD = jnp.where(causal, b[..., :, None] - b[..., None, :] + ib[..., None, :], -jnp.inf)
        inter = b + m[..., None]
        m_t = jnp.maximum(inter, jnp.max(logD, axis=-1))
        Dw = jnp.exp(logD - m_t[..., None])
        inter_w = jnp.exp(inter - m_t)
        s = jnp.einsum('bhtd,bhsd->bhts', qb, kb) * Dw
        num = inter_w[..., None] * jnp.einsum('bhtd,bhde->bhte', qb, C) \
            + jnp.einsum('bhts,bhse->bhte', s, vb)
        den = inter_w * jnp.einsum('bhtd,bhd->bht', qb, n) + jnp.sum(s, axis=-1)
        h = num / jnp.maximum(jnp.abs(den), jnp.exp(-m_t))[..., None]
        bL = b[..., -1]
        w_log = bL[..., None] - b + ib
        m_new = jnp.maximum(bL + m, jnp.max(w_log, axis=-1))
        decay = jnp.exp(bL + m - m_new)
        kw = kb * jnp.exp(w_log - m_new[..., None])[..., None]
        C_new = decay[..., None, None] * C + jnp.einsum('bhsd,bhse->bhde', kw, vb)
        n_new = decay[..., None] * n + jnp.sum(kw, axis=2)
        return (C_new, n_new, m_new), h

    init = (jnp.zeros((B, H, Dqk, Dv), jnp.float32),
            jnp.zeros((B, H, Dqk), jnp.float32),
            jnp.zeros((B, H), jnp.float32))
    _, hc = lax.scan(step, init, (qc, kc, vc, ic, fc))
    return jnp.moveaxis(hc, 0, 2).reshape(B, H, S, Dv)


def diff_attention(q, k, v, lam):
    B, H, _, S, Dh = q.shape
    NB = S // Q_BLOCK
    scale = Dh ** -0.5
    key_chunk = jnp.arange(S) // CHUNK
    qb = jnp.moveaxis(q.reshape(B, H, 2, NB, Q_BLOCK, Dh), 3, 0)
    v32 = v.astype(jnp.float32)

    def block(args):
        qblk, start = args
        s = jnp.einsum('bhcqd,bhckd->bhcqk', qblk, k,
                       preferred_element_type=jnp.float32) * scale
        q_chunk = (start + jnp.arange(Q_BLOCK)) // CHUNK
        mask = key_chunk[None, :] <= q_chunk[:, None]
        p = jax.nn.softmax(jnp.where(mask, s, -jnp.inf), axis=-1)
        a = p[:, :, 0] - lam * p[:, :, 1]
        return jnp.einsum('bhqk,bhkv->bhqv', a, v32)

    out = lax.map(block, (qb, jnp.arange(NB) * Q_BLOCK))
    return jnp.moveaxis(out, 0, 2).reshape(B, H, S, v.shape[-1])


def setup_inputs(seed: int = 0) -> dict:
    key = jax.random.key(seed)
    ks = jax.random.split(key, 20)
    f32 = jnp.float32

    def nrm(k, shape, s):
        return s * jax.random.normal(k, shape, f32)

    return {
        "x": nrm(ks[0], (BATCH, SEQ, D_MODEL), 1.0),
        "norm1_g": 1.0 + nrm(ks[1], (DEPTH, D_MODEL), 0.02),
        "w_in": nrm(ks[2], (DEPTH, D_MODEL, N_IN), D_MODEL ** -0.5),
        "conv_w": nrm(ks[3], (DEPTH, M_CONV, 2 * N_MQK), M_CONV ** -0.5),
        "conv_b": nrm(ks[4], (DEPTH, 2 * N_MQK), 0.02),
        "b_igate": nrm(ks[5], (DEPTH, M_HEADS), 0.1),
        "b_fgate": jnp.linspace(3.0, 6.0, M_HEADS, dtype=f32)[None, :] + nrm(ks[6], (DEPTH, M_HEADS), 0.1),
        "mnorm_g": 1.0 + nrm(ks[7], (DEPTH, M_HEADS, M_DV), 0.02),
        "lambda_q1": nrm(ks[8], (DEPTH, A_DH), 0.1),
        "lambda_k1": nrm(ks[9], (DEPTH, A_DH), 0.1),
        "lambda_q2": nrm(ks[10], (DEPTH, A_DH), 0.1),
        "lambda_k2": nrm(ks[11], (DEPTH, A_DH), 0.1),
        "subln_g": 1.0 + nrm(ks[12], (DEPTH, A_DV), 0.02),
        "w_out": nrm(ks[13], (DEPTH, M_WIDTH + A_WIDTH, D_MODEL), (M_WIDTH + A_WIDTH) ** -0.5),
        "norm2_g": 1.0 + nrm(ks[14], (DEPTH, D_MODEL), 0.02),
        "w_gate": nrm(ks[15], (DEPTH, D_MODEL, D_FF), D_MODEL ** -0.5),
        "w_up": nrm(ks[16], (DEPTH, D_MODEL, D_FF), D_MODEL ** -0.5),
        "w_down": nrm(ks[17], (DEPTH, D_FF, D_MODEL), D_FF ** -0.5),
        "final_g": 1.0 + nrm(ks[18], (D_MODEL,), 0.02),
    }


def reference(x, norm1_g, w_in, conv_w, conv_b, b_igate, b_fgate, mnorm_g,
              lambda_q1, lambda_k1, lambda_q2, lambda_k2, subln_g, w_out,
              norm2_g, w_gate, w_up, w_down, final_g):
    B, S, _ = x.shape
    pos = jnp.arange(S)
    for l in range(DEPTH):
        h = rmsnorm(x, norm1_g[l])
        proj = h @ w_in[l]
        mq, mk, mv, mo, mi, mf, aq, ak, av = split_proj(proj)

        qk = jax.nn.silu(causal_conv(jnp.concatenate([mq, mk], axis=-1), conv_w[l], conv_b[l]))
        mq, mk = qk[..., :N_MQK], qk[..., N_MQK:]
        mq = mq.reshape(B, S, M_HEADS, M_DQK).transpose(0, 2, 1, 3)
        mk = mk.reshape(B, S, M_HEADS, M_DQK).transpose(0, 2, 1, 3)
        mv_h = mv.reshape(B, S, M_HEADS, M_DV).transpose(0, 2, 1, 3)
        i_pre = GATE_CAP * jnp.tanh((mi + b_igate[l]).astype(jnp.float32) / GATE_CAP)
        f_pre = GATE_CAP * jnp.tanh((mf + b_fgate[l]).astype(jnp.float32) / GATE_CAP)
        hm = mlstm_chunkwise(mq, mk, mv_h, i_pre.transpose(0, 2, 1), f_pre.transpose(0, 2, 1))
        hm = rmsnorm(hm, mnorm_g[l][:, None, :]).astype(x.dtype)
        hm = hm.transpose(0, 2, 1, 3).reshape(B, S, M_WIDTH) * jax.nn.sigmoid(mo)

        aq_h = rope(aq.reshape(B, S, A_HEADS, 2, A_DH).transpose(0, 2, 3, 1, 4), pos)
        ak_h = rope(ak.reshape(B, S, A_HEADS, 2, A_DH).transpose(0, 2, 3, 1, 4), pos)
        av_h = av.reshape(B, S, A_HEADS, A_DV).transpose(0, 2, 1, 3)
        lam_init = 0.8 - 0.6 * math.exp(-0.3 * l)
        lam = (jnp.exp(jnp.sum(lambda_q1[l].astype(jnp.float32) * lambda_k1[l].astype(jnp.float32)))
               - jnp.exp(jnp.sum(lambda_q2[l].astype(jnp.float32) * lambda_k2[l].astype(jnp.float32)))
               + lam_init)
        ha = diff_attention(aq_h, ak_h, av_h, lam)
        ha = rmsnorm(ha, subln_g[l]) * (1.0 - lam_init)
        ha = ha.transpose(0, 2, 1, 3).reshape(B, S, A_WIDTH).astype(x.dtype)

        x = x + jnp.concatenate([hm, ha], axis=-1) @ w_out[l]

        h2 = rmsnorm(x, norm2_g[l])
        x = x + (jax.nn.silu(h2 @ w_gate[l]) * (h2 @ w_up[l])) @ w_down[l]
    return rmsnorm(x, final_g)
```

```cpp
#include <hip/hip_runtime.h>
#include <hip/hip_cooperative_groups.h>
#include <cstdio>
#include <cstdint>
#include <cmath>
namespace cg = cooperative_groups;
namespace pg8 {
#define PG8_LAS __attribute__((address_space(3)))
typedef unsigned short bf16_t;
typedef short bf16x8 __attribute__((ext_vector_type(8)));
typedef float f32x4 __attribute__((ext_vector_type(4)));
typedef unsigned u32x4 __attribute__((ext_vector_type(4)));
constexpr int BM = 256, BK = 64, HALF = 128, HTB = HALF * BK * 2  , STAGE_BYTES = 8 * HTB, NXCD = 8, WGM = 8;

__host__ __device__ __forceinline__ int lds_byte(int r, int c) { const int st = (r >> 4) * 2 + (c >> 5), rr = r & 15, cc = c & 31, ob = rr * 64 + cc * 2; return st * 1024 + (ob ^ (((ob >> 9) & 1) << 5)); }
__host__ __device__ __forceinline__ void stage_rc(int b, int& R, int& C) { const int st = b / 1024, sb = b % 1024, swz = sb ^ (((sb >> 9) & 1) << 5); R = (st >> 1) * 16 + swz / 64; C = (st & 1) * 32 + (swz % 64) / 2; }
__host__ __device__ __forceinline__ int perm32(int rho) { const int n = rho >> 4, i = rho & 15; return 8 * (i >> 2) + 4 * n + (i & 3); }

struct Unit { int pm, pn; };
struct Gemm { const bf16_t* A; const bf16_t* Bt; int M, N, K; };

struct StaticOrder {
    int nM, nN, nwg, G, c;
    __host__ __device__ void init(int M, int N, int G_, int c_) { nM = M / BM; nN = N / BM; nwg = nM * nN; G = G_; c = c_; }
    __host__ __device__ bool next(int i, Unit& u) const {
        const long L = (long)i * G + c; if (L >= nwg) return false;
        int wgid = (int)L; { const int q = nwg / NXCD, r = nwg % NXCD, xcd = wgid % NXCD, off = wgid / NXCD; wgid = (xcd < r ? xcd * (q + 1) : r * (q + 1) + (xcd - r) * q) + off; }
        const int nig = WGM * nN, gid = wgid / nig, fm = gid * WGM, gsz = (nM - fm) < WGM ? (nM - fm) : WGM;
        u.pm = fm + ((wgid % nig) % gsz); u.pn = (wgid % nig) / gsz; return true;
    }
    __device__ __forceinline__ void a_ready(const Unit&) const {}
    __device__ __forceinline__ void done(const Unit&) const {}
};

__device__ __forceinline__ unsigned cvt_pk_bf16(float lo, float hi) { unsigned r; asm volatile("v_cvt_pk_bf16_f32 %0, %1, %2" : "=v"(r) : "v"(lo), "v"(hi)); return r; }
typedef float f32x2 __attribute__((ext_vector_type(2)));
__device__ __forceinline__ f32x2 gelu_pk(f32x2 v) {
    const f32x2 av = __builtin_elementwise_abs(v), d = av * 0.2316418882f + 1.0f;
    f32x2 t; t.x = __builtin_amdgcn_rcpf(d.x); t.y = __builtin_amdgcn_rcpf(d.y);
    f32x2 q = t * 0.5307027145f + (-0.7265760135f); q = q * t + 0.7107068705f; q = q * t + (-0.142248368f); q = q * t + 0.127414796f; q = q * t;
    const f32x2 s = (v * v) * (-0.72134752044f);
    f32x2 e; e.x = __builtin_amdgcn_exp2f(s.x); e.y = __builtin_amdgcn_exp2f(s.y);
    const f32x2 m = v * (q * e), r = v - m;
    f32x2 o; o.x = v.x < 0.f ? m.x : r.x; o.y = v.y < 0.f ? m.y : r.y; return o;
}

template <int ACT  > struct EpiBf16 {
    static constexpr bool PERM = true, AFTER_DRAIN = false; static_assert(ACT == 0 || ACT == 1, "EpiBf16: ACT is 0 (none) or 1 (gelu_pk)");
    bf16_t* O; int ldc; const float* bias; int split_cols; size_t split_stride; float scale0;
    __device__ __forceinline__ void operator()(const f32x4 (&acc)[2][2][4][2], const Unit& u, int wr, int wc, int fr, int fq) const {
        const int row0 = u.pm * BM + wr * 64 + fr; int colt = u.pn * BM; bf16_t* base = O;
        float sc = 1.f; if (split_cols) { const int t = colt / split_cols; base += (size_t)t * split_stride; colt -= t * split_cols; if (t == 0) sc = scale0; }
        const int col0 = colt + wc * 32 + 8 * fq, bcol0 = u.pn * BM + wc * 32 + 8 * fq;
        f32x4 bv[2][2];
#pragma unroll
        for (int bj = 0; bj < 2; ++bj)
#pragma unroll
            for (int n = 0; n < 2; ++n) bv[bj][n] = bias ? *(const f32x4*)(bias + bcol0 + bj * HALF + 4 * n) : (f32x4){0.f, 0.f, 0.f, 0.f};
#pragma unroll
        for (int ai = 0; ai < 2; ++ai)
#pragma unroll
            for (int m = 0; m < 4; ++m) { bf16_t* rowp = base + (size_t)(row0 + ai * HALF + m * 16) * ldc + col0;
#pragma unroll
                for (int bj = 0; bj < 2; ++bj) { f32x4 v0 = acc[ai][bj][m][0] + bv[bj][0], v1 = acc[ai][bj][m][1] + bv[bj][1];
                    if (ACT == 1) { f32x2 a = gelu_pk((f32x2){v0[0], v0[1]}), b = gelu_pk((f32x2){v0[2], v0[3]}), c = gelu_pk((f32x2){v1[0], v1[1]}), d = gelu_pk((f32x2){v1[2], v1[3]});
                        v0 = (f32x4){a.x, a.y, b.x, b.y}; v1 = (f32x4){c.x, c.y, d.x, d.y}; }
                    v0 = v0 * sc; v1 = v1 * sc; u32x4 w; w.x = cvt_pk_bf16(v0[0], v0[1]); w.y = cvt_pk_bf16(v0[2], v0[3]); w.z = cvt_pk_bf16(v1[0], v1[1]); w.w = cvt_pk_bf16(v1[2], v1[3]);
                    *(u32x4*)(rowp + bj * HALF) = w; } }
    }
};
struct EpiProj {
    static constexpr bool PERM = true, AFTER_DRAIN = false;
    bf16_t* O; int ldc; const float* tab; float scale_q;
    __device__ __forceinline__ void operator()(const f32x4 (&acc)[2][2][4][2], const Unit& u, int wr, int wc, int fr, int fq) const {
        const int row0 = u.pm * BM + wr * 64 + fr, col0 = u.pn * BM + wc * 32 + 8 * fq;
        const bool rope = (u.pn >= 12 && u.pn < 20); const float sc = (u.pn >= 12 && u.pn < 16) ? scale_q : 1.0f;
        asm volatile("s_nop 15" ::: "memory");
#pragma unroll
        for (int ai = 0; ai < 2; ++ai)
#pragma unroll
            for (int m = 0; m < 4; ++m) { const int row = row0 + ai * HALF + m * 16; bf16_t* rowp = O + (size_t)row * ldc + col0;
#pragma unroll
                for (int bj = 0; bj < 2; ++bj) { f32x4 v0 = acc[ai][bj][m][0], v1 = acc[ai][bj][m][1];
                    if (rope) { const int dp = ((col0 + bj * HALF) & 63) >> 1;
                        const f32x4 cs0 = *(const f32x4*)(tab + ((size_t)row * 32 + dp) * 2), cs1 = *(const f32x4*)(tab + ((size_t)row * 32 + dp + 2) * 2);
                        const f32x4 a = v0, b = v1;
                        v0[0] = (a[0] * cs0[0] - a[1] * cs0[1]) * sc; v0[1] = (a[1] * cs0[0] + a[0] * cs0[1]) * sc; v0[2] = (a[2] * cs0[2] - a[3] * cs0[3]) * sc; v0[3] = (a[3] * cs0[2] + a[2] * cs0[3]) * sc;
                        v1[0] = (b[0] * cs1[0] - b[1] * cs1[1]) * sc; v1[1] = (b[1] * cs1[0] + b[0] * cs1[1]) * sc; v1[2] = (b[2] * cs1[2] - b[3] * cs1[3]) * sc; v1[3] = (b[3] * cs1[2] + b[2] * cs1[3]) * sc; }
                    u32x4 w; w.x = cvt_pk_bf16(v0[0], v0[1]); w.y = cvt_pk_bf16(v0[2], v0[3]); w.z = cvt_pk_bf16(v1[0], v1[1]); w.w = cvt_pk_bf16(v1[2], v1[3]);
                    *(u32x4*)(rowp + bj * HALF) = w; } }
    }
};
struct EpiResF32 {
    static constexpr bool PERM = false, AFTER_DRAIN = false;
    const float* base; float* out; int ldc;
    __device__ __forceinline__ void operator()(const f32x4 (&acc)[2][2][4][2], const Unit& u, int wr, int wc, int fr, int fq) const {
        const int row0 = u.pm * BM + wr * 64 + fr, col0 = u.pn * BM + wc * 32 + 4 * fq;
#pragma unroll
        for (int ai = 0; ai < 2; ++ai)
#pragma unroll
            for (int m = 0; m < 4; ++m) { const size_t off = (size_t)(row0 + ai * HALF + m * 16) * ldc + col0;
#pragma unroll
                for (int bj = 0; bj < 2; ++bj)
#pragma unroll
                    for (int n = 0; n < 2; ++n) { const f32x4 b = *(const f32x4*)(base + off + bj * HALF + n * 16); *(f32x4*)(out + off + bj * HALF + n * 16) = b + acc[ai][bj][m][n]; } }
    }
};
struct EpiSwiGLU {
    static constexpr bool PERM = true, AFTER_DRAIN = false;
    bf16_t* O; int ldc;
    __device__ __forceinline__ void operator()(const f32x4 (&acc)[2][2][4][2], const Unit& u, int wr, int wc, int fr, int fq) const {
        const int row0 = u.pm * BM + wr * 64 + fr, col0 = u.pn * HALF + wc * 32 + 8 * fq;
#pragma unroll
        for (int ai = 0; ai < 2; ++ai)
#pragma unroll
            for (int m = 0; m < 4; ++m) { bf16_t* rowp = O + (size_t)(row0 + ai * HALF + m * 16) * ldc + col0;
                float r[8];
#pragma unroll
                for (int n = 0; n < 2; ++n)
#pragma unroll
                    for (int i = 0; i < 4; ++i) { const float g = acc[ai][0][m][n][i], up = acc[ai][1][m][n][i]; r[4 * n + i] = g * __builtin_amdgcn_rcpf(1.0f + __expf(-g)) * up; }
                u32x4 w; w.x = cvt_pk_bf16(r[0], r[1]); w.y = cvt_pk_bf16(r[2], r[3]); w.z = cvt_pk_bf16(r[4], r[5]); w.w = cvt_pk_bf16(r[6], r[7]);
                *(u32x4*)rowp = w; }
    }
};
template <class Epi, class Sched, bool ALIGN_EPI = false, bool SP2 = false>
__device__ __forceinline__ void gemm_phase(PG8_LAS unsigned char* lds, const Gemm g, const Sched& S, const Epi& E) {
    int tid_ = threadIdx.x; asm volatile("" : "+v"(tid_));
    const int tid = tid_, wid = __builtin_amdgcn_readfirstlane(tid >> 6), lane = tid & 63, wr = wid >> 2, wc = wid & 3, fr = lane & 15, fq = lane >> 4;
    const int K = g.K, nt = K / BK;
    unsigned voffA[2], voffB[2];
#pragma unroll
    for (int i = 0; i < 2; ++i) { int R, C; stage_rc(tid * 16 + i * 8192, R, C); const int Rb = Epi::PERM ? ((R & ~31) + perm32(R & 31)) : R;
        voffA[i] = (unsigned)(R * K + C) * 2u; voffB[i] = (unsigned)(Rb * K + C) * 2u; }
    const size_t kstep = (size_t)(BK * 2);
    const size_t hstep = (size_t)HALF * K * 2;
    const size_t tstep = 2 * hstep;
    const unsigned ldsw = (unsigned)wid * 1024u;
    const int aoff = lds_byte(wr * 64 + fr, fq * 8), boff = lds_byte(wc * 32 + fr, fq * 8);
#define PG8_SA(b, h) (((b) * 2 + (h)) * HTB)
#define PG8_SB(b, h) ((4 + (b) * 2 + (h)) * HTB)
#define PG8_STAGE(bufoff, gbase, voff) do { _Pragma("unroll") for (int _i = 0; _i < 2; ++_i) \
        __builtin_amdgcn_global_load_lds((const unsigned*)((const char*)(gbase) + (voff)[_i]), (PG8_LAS unsigned*)(lds + (bufoff) + ldsw + _i * 8192), 16, 0, 0); } while (0)
#define PG8_LDA(dst, b, h) do { _Pragma("unroll") for (int m = 0; m < 4; ++m) _Pragma("unroll") for (int k = 0; k < 2; ++k) dst[m][k] = *(const PG8_LAS bf16x8*)(lds + PG8_SA(b, h) + aoff + m * 2048 + k * 1024); } while (0)
#define PG8_LDB(dst, b, h) do { _Pragma("unroll") for (int n = 0; n < 2; ++n) _Pragma("unroll") for (int k = 0; k < 2; ++k) dst[n][k] = *(const PG8_LAS bf16x8*)(lds + PG8_SB(b, h) + boff + n * 2048 + k * 1024); } while (0)
#define PG8_MMA(ai, bj, At, Bt) do { __builtin_amdgcn_s_setprio(1); _Pragma("unroll") for (int m = 0; m < 4; ++m) _Pragma("unroll") for (int n = 0; n < 2; ++n) _Pragma("unroll") for (int k = 0; k < 2; ++k) \
        acc[ai][bj][m][n] = __builtin_amdgcn_mfma_f32_16x16x32_bf16(Bt[n][k], At[m][k], acc[ai][bj][m][n], 0, 0, 0); __builtin_amdgcn_s_setprio(0); } while (0)
#define PG8_WAIT_V(n) asm volatile("s_waitcnt vmcnt(" #n ")" ::: "memory")
#define PG8_WAIT_L(n) asm volatile("s_waitcnt lgkmcnt(" #n ")" ::: "memory")
#define PG8_BAR __builtin_amdgcn_s_barrier()
#define PG8_SCHED __builtin_amdgcn_sched_barrier(0)
    Unit cur, nxt; int ui = 0;
    if (!S.next(0, cur)) return;
    f32x4 acc[2][2][4][2];
#pragma unroll
    for (int a = 0; a < 2; ++a)
#pragma unroll
        for (int b = 0; b < 2; ++b)
#pragma unroll
            for (int m = 0; m < 4; ++m)
#pragma unroll
                for (int n = 0; n < 2; ++n) acc[a][b][m][n] = (f32x4){0.f, 0.f, 0.f, 0.f};
    bf16x8 At[4][2], B0[2][2], B1[2][2];
    const char* cA = (const char*)g.A + (size_t)cur.pm * tstep; const char* cB = (const char*)g.Bt + (size_t)cur.pn * tstep;
    S.a_ready(cur);
    if constexpr (SP2) {
        PG8_STAGE(PG8_SB(0, 0), cB, voffB); PG8_STAGE(PG8_SB(0, 1), cB + hstep, voffB); PG8_STAGE(PG8_SA(0, 0), cA, voffA); PG8_STAGE(PG8_SA(0, 1), cA + hstep, voffA);
        if (wr == 1) PG8_BAR;
        PG8_WAIT_V(2); PG8_BAR;
        PG8_STAGE(PG8_SB(1, 0), cB + kstep, voffB); PG8_STAGE(PG8_SA(1, 0), cA + kstep, voffA); PG8_STAGE(PG8_SB(1, 1), cB + hstep + kstep, voffB);
        PG8_WAIT_V(6); PG8_BAR;
    } else {
        PG8_STAGE(PG8_SB(0, 0), cB, voffB); PG8_STAGE(PG8_SA(0, 0), cA, voffA); PG8_STAGE(PG8_SB(0, 1), cB + hstep, voffB); PG8_STAGE(PG8_SA(0, 1), cA + hstep, voffA);
        if (wr == 1) PG8_BAR;
        PG8_WAIT_V(4); PG8_BAR;
        PG8_STAGE(PG8_SB(1, 0), cB + kstep, voffB); PG8_STAGE(PG8_SA(1, 0), cA + kstep, voffA); PG8_STAGE(PG8_SB(1, 1), cB + hstep + kstep, voffB);
        PG8_WAIT_V(6); PG8_BAR;
    }
    for (;;) {
        const bool has_next = S.next(ui + 1, nxt);
        const char* nA = has_next ? (const char*)g.A + (size_t)nxt.pm * tstep : cA; const char* nB = has_next ? (const char*)g.Bt + (size_t)nxt.pn * tstep : cB;
        for (int t = 0; t < nt; t += 2) {
            const bool last = (t == nt - 2);
            const char* a1 = cA + (size_t)(t + 1) * kstep;
            const char* a2 = last ? nA : cA + (size_t)(t + 2) * kstep; const char* b2 = last ? nB : cB + (size_t)(t + 2) * kstep;
            const char* a3 = a2 + kstep; const char* b3 = b2 + kstep;
            if (last && has_next) S.a_ready(nxt);
            if constexpr (SP2) {
            PG8_LDB(B0, 0, 0); PG8_LDB(B1, 0, 1); PG8_SCHED; PG8_LDA(At, 0, 0); PG8_STAGE(PG8_SA(1, 1), a1 + hstep, voffA);
            PG8_WAIT_V(8); PG8_WAIT_L(0); PG8_BAR; PG8_MMA(0, 0, At, B0); PG8_MMA(0, 1, At, B1); PG8_BAR; PG8_SCHED;
            PG8_LDA(At, 0, 1); PG8_STAGE(PG8_SB(0, 0), b2, voffB); PG8_STAGE(PG8_SB(0, 1), b2 + hstep, voffB); PG8_STAGE(PG8_SA(0, 0), a2, voffA);
            PG8_WAIT_V(8); PG8_WAIT_L(0); PG8_BAR; PG8_MMA(1, 0, At, B0); PG8_MMA(1, 1, At, B1); PG8_BAR; PG8_SCHED;
            PG8_LDB(B0, 1, 0); PG8_LDB(B1, 1, 1); PG8_SCHED; PG8_LDA(At, 1, 0); PG8_STAGE(PG8_SA(0, 1), a2 + hstep, voffA);
            PG8_WAIT_V(8); PG8_WAIT_L(0); PG8_BAR; PG8_MMA(0, 0, At, B0); PG8_MMA(0, 1, At, B1); PG8_BAR; PG8_SCHED;
            PG8_LDA(At, 1, 1); PG8_STAGE(PG8_SB(1, 0), b3, voffB); PG8_STAGE(PG8_SB(1, 1), b3 + hstep, voffB); PG8_STAGE(PG8_SA(1, 0), a3, voffA);
            PG8_WAIT_V(8); PG8_WAIT_L(0); PG8_BAR; PG8_MMA(1, 0, At, B0); PG8_MMA(1, 1, At, B1); PG8_BAR; PG8_SCHED;
            } else {
            PG8_LDB(B0, 0, 0); PG8_SCHED; PG8_LDA(At, 0, 0); PG8_STAGE(PG8_SA(1, 1), a1 + hstep, voffA);
            PG8_WAIT_L(8); PG8_BAR; PG8_WAIT_L(0); PG8_MMA(0, 0, At, B0); PG8_BAR; PG8_SCHED;
            PG8_LDB(B1, 0, 1); PG8_STAGE(PG8_SB(0, 0), b2, voffB);
            PG8_BAR; PG8_WAIT_L(0); PG8_MMA(0, 1, At, B1); PG8_BAR;
            PG8_LDA(At, 0, 1); PG8_STAGE(PG8_SA(0, 0), a2, voffA);
            PG8_BAR; PG8_WAIT_L(0); PG8_MMA(1, 0, At, B0); PG8_BAR; PG8_SCHED;
            PG8_STAGE(PG8_SB(0, 1), b2 + hstep, voffB);
            PG8_WAIT_V(6); PG8_BAR; PG8_MMA(1, 1, At, B1); PG8_BAR;
            PG8_LDB(B0, 1, 0); PG8_SCHED; PG8_LDA(At, 1, 0); PG8_STAGE(PG8_SA(0, 1), a2 + hstep, voffA);
            PG8_WAIT_L(8); PG8_BAR; PG8_WAIT_L(0); PG8_MMA(0, 0, At, B0); PG8_BAR; PG8_SCHED;
            PG8_LDB(B1, 1, 1); PG8_STAGE(PG8_SB(1, 0), b3, voffB);
            PG8_BAR; PG8_WAIT_L(0); PG8_MMA(0, 1, At, B1); PG8_BAR;
            PG8_LDA(At, 1, 1); PG8_STAGE(PG8_SA(1, 0), a3, voffA);
            PG8_BAR; PG8_WAIT_L(0); PG8_MMA(1, 0, At, B0); PG8_BAR; PG8_SCHED;
            PG8_STAGE(PG8_SB(1, 1), b3 + hstep, voffB);
            PG8_WAIT_V(6); PG8_BAR; PG8_MMA(1, 1, At, B1); PG8_BAR;
            }
        }
        if constexpr (ALIGN_EPI) { if (wr == 0) PG8_BAR; }
        if constexpr (!Epi::AFTER_DRAIN) { E(acc, cur, wr, wc, fr, fq); S.done(cur); }
        if (!has_next) break;
#pragma unroll
        for (int a = 0; a < 2; ++a)
#pragma unroll
            for (int b = 0; b < 2; ++b)
#pragma unroll
                for (int m = 0; m < 4; ++m)
#pragma unroll
                    for (int n = 0; n < 2; ++n) acc[a][b][m][n] = (f32x4){0.f, 0.f, 0.f, 0.f};
        cur = nxt; cA = nA; cB = nB; ++ui;
        if constexpr (ALIGN_EPI) { if (wr == 1) PG8_BAR; }
    }
    PG8_WAIT_V(0);
    if constexpr (!ALIGN_EPI) { if (wr == 0) PG8_BAR; }
    PG8_BAR;
    if constexpr (Epi::AFTER_DRAIN) { E.fused(acc, cur, wr, wc, fr, fq, lds, wid, lane); S.done(cur); }
#undef PG8_SA
#undef PG8_SB
#undef PG8_STAGE
#undef PG8_LDA
#undef PG8_LDB
#undef PG8_MMA
#undef PG8_WAIT_V
#undef PG8_WAIT_L
#undef PG8_BAR
#undef PG8_SCHED
}
}

#ifndef PG8_SP2
#define PG8_SP2 true
#endif
#ifndef PG8_ALIGN
#define PG8_ALIGN true
#endif
#include <hip/hip_bf16.h>
namespace attn128 {
using bf16=__hip_bfloat16;
using bf16x8=__attribute__((ext_vector_type(8)))short;
using s16x4=__attribute__((ext_vector_type(4)))short;
using f32x16=__attribute__((ext_vector_type(16)))float;
using u32x4=__attribute__((ext_vector_type(4)))unsigned;
constexpr int SEQ=16384,PIN=6144,POUT=2048,QB=256,NQB=SEQ/QB;
constexpr int KBUF=8192,VBUF=16384;
constexpr int LDS_K=0,LDS_V=3*KBUF,LDS_OST=0,LDS_WS=65536,LDS_Q=LDS_WS+8*64*4,LDS_BYTES=LDS_Q+8*4096;
constexpr float C2=0.125f*1.4426950408889634f;
__device__ __forceinline__ int crow(int r,int hi){return (r&3)+8*(r>>2)+4*hi;}
__device__ __forceinline__ void glds16(const void*gsrc,unsigned lds_dst){unsigned keep;
  asm volatile("s_mov_b32 %0, m0\n\ts_mov_b32 m0, %2\n\ts_nop 0\n\tglobal_load_lds_dwordx4 %1, off\n\ts_mov_b32 m0, %0":"=&s"(keep):"v"(gsrc),"s"(lds_dst):"memory");}
__device__ __forceinline__ void glds16s(const void*sbase,unsigned voff,unsigned lds_dst){unsigned keep;
  asm volatile("s_mov_b32 %0, m0\n\ts_mov_b32 m0, %3\n\ts_nop 0\n\tglobal_load_lds_dwordx4 %1, %2\n\ts_mov_b32 m0, %0":"=&s"(keep):"v"(voff),"s"(sbase),"s"(lds_dst):"memory");}
typedef float f32x2_t __attribute__((ext_vector_type(2))); typedef __bf16 bf16x2_t __attribute__((ext_vector_type(2)));
__device__ __forceinline__ unsigned cvtpk_s(float lo,float hi){f32x2_t v={lo,hi};bf16x2_t b=__builtin_convertvector(v,bf16x2_t);return __builtin_bit_cast(unsigned,b);}
__device__ __forceinline__ float max3f(float a,float b,float c){float r;asm("v_max3_f32 %0, %1, %2, %3":"=v"(r):"v"(a),"v"(b),"v"(c));return r;}
__device__ __forceinline__ float max2f(float a,float b){float r;asm("v_max_f32_e32 %0, %1, %2":"=v"(r):"v"(a),"v"(b));return r;}
typedef __attribute__((address_space(3))) const char* lds_cptr;
typedef short v4i16_t __attribute__((ext_vector_type(4)));
__device__ __forceinline__ s16x4 vtr(lds_cptr p){ return __builtin_bit_cast(s16x4,__builtin_amdgcn_ds_read_tr16_b64_v4i16((__attribute__((address_space(3))) v4i16_t*)p)); }
#define A128_WAITBAR() asm volatile("s_waitcnt vmcnt(0) lgkmcnt(0)\n\ts_barrier":::"memory")
#define SB() __builtin_amdgcn_sched_barrier(0)
#define LDSQ(p) (*(const __attribute__((address_space(3))) bf16x8*)(p))
#define MF32(a,b,c) __builtin_amdgcn_mfma_f32_32x32x16_bf16(a,b,c,0,0,0)
#define EXP1(x) x=__builtin_amdgcn_exp2f((x)-mh_)
struct St { float mhat,l_reg; f32x16 o[4]; };
template<bool GUARD> __device__ __forceinline__ float rowmax32(f32x16&p0,f32x16&p1){
  if(GUARD) asm volatile("s_nop 15\n\ts_nop 7":"+v"(p0),"+v"(p1));
  float a=max3f(p0[0],p0[1],p1[0]),b=max3f(p0[2],p0[3],p1[1]);a=max3f(a,p1[2],p1[3]);
  #pragma unroll
  for(int r=4;r<16;r+=4){a=max3f(a,p0[r],p0[r+1]);b=max3f(b,p0[r+2],p0[r+3]);a=max3f(a,p1[r],p1[r+1]);b=max3f(b,p1[r+2],p1[r+3]);}
  const float m=max2f(a,b); auto rr=__builtin_amdgcn_permlane32_swap(__float_as_uint(m),__float_as_uint(m),false,false);
  return max2f(__uint_as_float(rr[0]),__uint_as_float(rr[1]));
}
template<int THRL,bool FIRST> __device__ __forceinline__ void decide(float rm,St&S,float*wsf,int r32,int hi){
  if(FIRST){ S.mhat=rm; }
  else if(__any(rm-S.mhat>(float)THRL)){
    const float dl=__builtin_fmaxf(rm-S.mhat,0.f); S.mhat+=dl;
    const float f=__builtin_amdgcn_exp2f(-dl); S.l_reg*=f; if(hi==0)wsf[r32]=f;
    asm volatile("s_waitcnt lgkmcnt(0)":::"memory");
    #pragma unroll
    for(int r=0;r<16;++r){ const float fr=wsf[crow(r,hi)];
      #pragma unroll
      for(int d=0;d<4;++d)S.o[d][r]*=fr; }
  }
}
template<int THRL,bool FIRST> __device__ __forceinline__ void softmax_head(f32x16&p0,f32x16&p1,St&S,float*wsf,int r32,int hi){ decide<THRL,FIRST>(rowmax32<true>(p0,p1),S,wsf,r32,hi); }
__device__ __forceinline__ bf16x8 vfrag(lds_cptr vp,int i){ const s16x4 lo=vtr(vp+(i&3)*4096+(i>>2)*1024), hh=vtr(vp+(i&3)*4096+(i>>2)*1024+512); return (bf16x8){lo[0],lo[1],lo[2],lo[3],hh[0],hh[1],hh[2],hh[3]}; }
__device__ __forceinline__ u32x4 packw(const f32x16&p,int base){ u32x4 w; w[0]=cvtpk_s(p[base],p[base+1]); w[1]=cvtpk_s(p[base+2],p[base+3]); w[2]=cvtpk_s(p[base+4],p[base+5]); w[3]=cvtpk_s(p[base+6],p[base+7]); return w; }
__device__ __forceinline__ void qk_plain(f32x16&n0,f32x16&n1,lds_cptr kp,lds_cptr qp){
  bf16x8 qa=LDSQ(qp),qb=LDSQ(qp+1024); const f32x16 z=f32x16{};
  n0=MF32(LDSQ(kp),qa,z); n1=MF32(LDSQ(kp+512),qa,z); qa=LDSQ(qp+2048);
  n0=MF32(LDSQ(kp+2048),qb,n0); n1=MF32(LDSQ(kp+2560),qb,n1); qb=LDSQ(qp+3072);
  n0=MF32(LDSQ(kp+4096),qa,n0); n1=MF32(LDSQ(kp+4608),qa,n1);
  n0=MF32(LDSQ(kp+6144),qb,n0); n1=MF32(LDSQ(kp+6656),qb,n1);
}
__device__ __forceinline__ void expsum_pv_plain(f32x16&p0,f32x16&p1,St&S,lds_cptr vp){
  float s=0.f; const float mh_=S.mhat;
  #pragma unroll
  for(int r=0;r<16;++r){EXP1(p0[r]);EXP1(p1[r]);s+=p0[r]+p1[r];}
  S.l_reg+=s;
  u32x4 pw[4]; pw[0]=packw(p0,0); pw[1]=packw(p0,8); pw[2]=packw(p1,0); pw[3]=packw(p1,8);
  #pragma unroll
  for(int i=0;i<16;++i){ const bf16x8 vf=vfrag(vp,i); S.o[i&3]=MF32(__builtin_bit_cast(bf16x8,pw[i>>2]),vf,S.o[i&3]); }
}
template<int THRL,bool FIRST> __device__ __forceinline__ void step_main(f32x16&p0,f32x16&p1,f32x16&n0,f32x16&n1,St&S,lds_cptr kpn,lds_cptr qp,lds_cptr vp,float*wsf,int r32,int hi,float&rm){
  #define KF(i) LDSQ(kpn+((i)>>1)*2048+((i)&1)*512)
  #define QF(d0) LDSQ(qp+(d0)*1024)
  bf16x8 ka=KF(0),kb=KF(1),kc=KF(2),kd=KF(3),qa=QF(0),qb=QF(1);
  decide<THRL,FIRST>(rm,S,wsf,r32,hi);
  u32x4 pw0,pw1,pw2,pw3; const float mh_=S.mhat; const f32x16 z=f32x16{};
  SB();
  n0=MF32(ka,qa,z); ka=KF(4); EXP1(p0[0]);EXP1(p0[1]);EXP1(p0[2]); SB();
  n1=MF32(kb,qa,z); kb=KF(5); qa=QF(2); EXP1(p0[3]);EXP1(p0[4]);EXP1(p0[5]); SB();
  n0=MF32(kc,qb,n0);   kc=KF(6); EXP1(p0[6]);EXP1(p0[7]);EXP1(p0[8]); SB();
  n1=MF32(kd,qb,n1);   kd=KF(7); qb=QF(3); EXP1(p0[9]);EXP1(p0[10]);EXP1(p0[11]); SB();
  bf16x8 vfa=vfrag(vp,0);
  n0=MF32(ka,qa,n0);   EXP1(p0[12]);EXP1(p0[13]);EXP1(p0[14]); pw0=packw(p0,0); SB();
  bf16x8 vfb=vfrag(vp,1);
  n1=MF32(kb,qa,n1);   EXP1(p0[15]);EXP1(p1[0]);EXP1(p1[1]); SB();
  bf16x8 vfc=vfrag(vp,2);
  n0=MF32(kc,qb,n0);   EXP1(p1[2]);EXP1(p1[3]);EXP1(p1[4]); pw1=packw(p0,8); SB();
  bf16x8 vfd=vfrag(vp,3);
  n1=MF32(kd,qb,n1);   EXP1(p1[5]);EXP1(p1[6]);EXP1(p1[7]); SB();
  #undef KF
  #undef QF
  float sa=p0[0]+p0[1];
  #define PVG(i,PW,VF,NEXTI,X0,X1,Y0,Y1,EXTRA) do{ S.o[(i)&3]=MF32(__builtin_bit_cast(bf16x8,PW),VF,S.o[(i)&3]); if((NEXTI)<16){ VF=vfrag(vp,(NEXTI)<16?(NEXTI):0); } sa+=X0; sa+=X1; sa+=Y0; sa+=Y1; EXTRA; SB(); }while(0)
  PVG(0,pw0,vfa,4, p0[2],p0[3],p0[4],p0[5],   do{EXP1(p1[8]);EXP1(p1[9]);}while(0));
  PVG(1,pw0,vfb,5, p0[6],p0[7],p0[8],p0[9], do{EXP1(p1[10]);EXP1(p1[11]);}while(0));
  PVG(2,pw0,vfc,6, p0[10],p0[11],p0[12],p0[13], do{EXP1(p1[12]);EXP1(p1[13]);}while(0));
  PVG(3,pw0,vfd,7, p0[14],p0[15],p1[0],p1[1],   do{EXP1(p1[14]);EXP1(p1[15]);}while(0));
  PVG(4,pw1,vfa,8, p1[2],p1[3],p1[4],p1[5],   pw2=packw(p1,0));
  PVG(5,pw1,vfb,9, p1[6],p1[7],p1[8],p1[9], pw3=packw(p1,8));
  PVG(6,pw1,vfc,10, p1[10],p1[11],p1[12],p1[13], do{}while(0));
  PVG(7,pw1,vfd,11, p1[14],p1[15],0.f,0.f, do{}while(0));
  float ma,mb;
  #define PINAB() asm volatile("":"+v"(ma),"+v"(mb))
  PVG(8,pw2,vfa,12,0.f,0.f,0.f,0.f, do{ma=max3f(n0[0],n0[1],n1[0]);mb=max3f(n0[2],n0[3],n1[1]);PINAB();}while(0));
  PVG(9,pw2,vfb,13,0.f,0.f,0.f,0.f, do{ma=max3f(ma,n1[2],n1[3]);mb=max3f(mb,n0[4],n0[5]);PINAB();}while(0));
  PVG(10,pw2,vfc,14,0.f,0.f,0.f,0.f, do{ma=max3f(ma,n0[6],n0[7]);mb=max3f(mb,n1[4],n1[5]);PINAB();}while(0));
  PVG(11,pw2,vfd,15,0.f,0.f,0.f,0.f, do{ma=max3f(ma,n1[6],n1[7]);mb=max3f(mb,n0[8],n0[9]);PINAB();}while(0));
  PVG(12,pw3,vfa,16,0.f,0.f,0.f,0.f, do{ma=max3f(ma,n0[10],n0[11]);mb=max3f(mb,n1[8],n1[9]);PINAB();}while(0));
  PVG(13,pw3,vfb,16,0.f,0.f,0.f,0.f, do{ma=max3f(ma,n1[10],n1[11]);mb=max3f(mb,n0[12],n0[13]);PINAB();}while(0));
  PVG(14,pw3,vfc,16,0.f,0.f,0.f,0.f, do{ma=max3f(ma,n0[14],n0[15]);mb=max3f(mb,n1[12],n1[13]);PINAB();}while(0));
  PVG(15,pw3,vfd,16,0.f,0.f,0.f,0.f, do{ma=max3f(ma,n1[14],n1[15]);ma=max2f(ma,mb);PINAB();}while(0));
  #undef PINAB
  { auto rr=__builtin_amdgcn_permlane32_swap(__float_as_uint(ma),__float_as_uint(ma),false,false); rm=max2f(__uint_as_float(rr[0]),__uint_as_float(rr[1])); }
  #undef PVG
  S.l_reg+=sa;
}
template<int THRL> __device__ __forceinline__ void unit(int qb,const bf16*Q,const bf16*K,const bf16*V,bf16*O,char*shm){
  int tid_=threadIdx.x; asm volatile("":"+v"(tid_));
  const int tid=tid_,lane=tid&63,r32=lane&31,hi=lane>>5; const int wid=__builtin_amdgcn_readfirstlane(tid>>6);
  const int q0=qb*QB;
  const bf16*Qw=Q+(long)(q0+wid*32)*PIN;
  const unsigned lds0=(unsigned)(uintptr_t)shm;
  float*wsf=(float*)(shm+LDS_WS)+wid*64;
  const unsigned koff=(unsigned)(lane*PIN+wid*8)*2u;
  const unsigned voff=(unsigned)((16*(wid&3)+(lane>>2))*PIN+(wid>>2)*32+(lane&3)*8)*2u;
  const unsigned kdst=lds0+LDS_K+wid*1024, vdst=lds0+LDS_V+wid*1024;
  #define DMA_K(t,so) glds16s((const char*)K+(size_t)(t)*(64*PIN*2),koff,(unsigned)__builtin_amdgcn_readfirstlane(kdst+(so)))
  #define DMA_V(t,so) do{ glds16s((const char*)V+(size_t)(t)*(64*PIN*2),voff,(unsigned)__builtin_amdgcn_readfirstlane(vdst+(so))); glds16s((const char*)V+(size_t)(t)*(64*PIN*2)+128,voff,(unsigned)__builtin_amdgcn_readfirstlane(vdst+(so)+8192)); }while(0)
  const lds_cptr shm3=(lds_cptr)shm; const lds_cptr kp0=shm3+LDS_K+hi*1024+r32*16; const lds_cptr vp0=shm3+LDS_V+((lane>>4)&1)*32+(lane&3)*8+(4*hi+((lane&15)>>2))*64;
  const lds_cptr qp=shm3+LDS_Q+wid*4096+hi*512+r32*16;
  const int NT=(q0+QB)/64, g=wid>>1;
  DMA_K(0,0); DMA_V(0,0); DMA_K(1,KBUF);
  { bf16x8 qt[4];
    #pragma unroll
    for(int d0=0;d0<4;++d0)qt[d0]=*reinterpret_cast<const bf16x8*>(&Qw[(long)r32*PIN+d0*16+hi*8]);
    #pragma unroll
    for(int d0=0;d0<4;++d0)*(__attribute__((address_space(3))) bf16x8*)(shm3+LDS_Q+wid*4096+hi*512+r32*16+d0*1024)=qt[d0]; }
  St S; S.mhat=0.f; S.l_reg=0.f;
  #pragma unroll
  for(int d=0;d<4;++d)S.o[d]=f32x16{};
  A128_WAITBAR();
  f32x16 pA0,pA1,pB0,pB1;
  qk_plain(pA0,pA1,kp0,qp);
  float rm=0.f;
  int ks1=KBUF, ks2=2*KBUF;
  #define ROT() do{ ks1=ks2; ks2=(ks2==2*KBUF)?0:ks2+KBUF; }while(0)
  int t=0;
  if(NT>4){
    rm=rowmax32<true>(pA0,pA1);
    DMA_K(2,ks2); DMA_V(1,VBUF);
    step_main<THRL,true>(pA0,pA1,pB0,pB1,S,kp0+ks1,qp,vp0,wsf,r32,hi,rm); A128_WAITBAR(); ROT();
    DMA_K(3,ks2); DMA_V(2,0);
    step_main<THRL,false>(pB0,pB1,pA0,pA1,S,kp0+ks1,qp,vp0+VBUF,wsf,r32,hi,rm); A128_WAITBAR(); ROT();
    for(t=2;t<NT-4;t+=2){
      DMA_K(t+2,ks2); DMA_V(t+1,VBUF);
      step_main<THRL,false>(pA0,pA1,pB0,pB1,S,kp0+ks1,qp,vp0,wsf,r32,hi,rm); A128_WAITBAR(); ROT();
      DMA_K(t+3,ks2); DMA_V(t+2,0);
      step_main<THRL,false>(pB0,pB1,pA0,pA1,S,kp0+ks1,qp,vp0+VBUF,wsf,r32,hi,rm); A128_WAITBAR(); ROT();
    }
  }
  #define BAND(jb,P0,P1,N0,N1,VOFF) do{ const int tt=NT-4+(jb); \
      if((jb)+2<4) DMA_K(tt+2,ks2); if((jb)+1<4) DMA_V(tt+1,(VOFF)^VBUF); \
      if((jb)<=g){ if(tt==0) softmax_head<THRL,true>(P0,P1,S,wsf,r32,hi); else softmax_head<THRL,false>(P0,P1,S,wsf,r32,hi); } \
      if((jb)+1<4&&(jb)+1<=g) qk_plain(N0,N1,kp0+ks1,qp); \
      if((jb)<=g) expsum_pv_plain(P0,P1,S,vp0+(VOFF)); \
      A128_WAITBAR(); ROT(); }while(0)
  BAND(0,pA0,pA1,pB0,pB1,0);
  BAND(1,pB0,pB1,pA0,pA1,VBUF);
  BAND(2,pA0,pA1,pB0,pB1,0);
  BAND(3,pB0,pB1,pA0,pA1,VBUF);
  #undef BAND
  #undef ROT
  float l_reg=S.l_reg;
  {auto rr=__builtin_amdgcn_permlane32_swap(__float_as_uint(l_reg),__float_as_uint(l_reg),false,false);l_reg=__uint_as_float(rr[0])+__uint_as_float(rr[1]);}
  if(hi==0)wsf[32+r32]=l_reg; asm volatile("s_waitcnt lgkmcnt(0)":::"memory");
  bf16*Ow=O+(long)(q0+wid*32)*POUT;
  { bf16*stg=(bf16*)(shm+LDS_OST)+wid*4096;
    #pragma unroll
    for(int r=0;r<16;++r){ const int orow=crow(r,hi); const float rl=__builtin_amdgcn_rcpf(wsf[32+orow]);
      #pragma unroll
      for(int d=0;d<4;++d)stg[orow*128+d*32+r32]=__float2bfloat16(S.o[d][r]*rl); }
    asm volatile("s_waitcnt lgkmcnt(0)":::"memory");
    #pragma unroll
    for(int i=0;i<8;++i){ const int row=i*4+(lane>>4),ch=lane&15; const u32x4 v=*(const u32x4*)(stg+row*128+ch*8); *(u32x4*)(Ow+(long)row*POUT+ch*8)=v; } }
  asm volatile("s_waitcnt lgkmcnt(0)\n\ts_barrier":::"memory");
  #undef DMA_K
  #undef DMA_V
}
struct AttnTensors { const bf16* QKV; bf16* O; };
template<int THRL=8> __device__ __forceinline__ void attn_phase(char*lds,const AttnTensors&T,int grid,int block,int i_hi=3,int i_lo=0){
  for(int v0=block;v0<256;v0+=grid){
    const int vcu=(v0%8)*32+v0/8, hc=vcu>>4, s=vcu&15, h=hc>>1;
    const bf16*Q=T.QKV+3072+hc*64,*K=T.QKV+4096+hc*64,*V=T.QKV+5120+h*128; bf16*O=T.O+hc*128;
    for(int i=i_hi;i>=i_lo;--i){ const int qb=(i&1)?(32*(i>>1)+31-s):(32*(i>>1)+s); unit<THRL>(qb,Q,K,V,O,lds); }
  }
}
#undef A128_WAITBAR
}
constexpr int M = 16384, DM = 2048, NPROJ = 6144, FF = 5632, NGU = 2 * FF;
constexpr int MH = 4, DQK = 128, DV = 256, CH = 64, NCH = M / CH;
constexpr float EPS = 1e-6f;
constexpr float LAM_INIT = 0.2f;
constexpr int PC_MV = 1024, PC_MO = 2048, PC_AQ = 3072;
constexpr size_t MiB = 1u << 20;
constexpr size_t WS_GATES = 0;
constexpr size_t WS_LOGF = 512 * 1024;
constexpr size_t WS_IG = 768 * 1024;
constexpr size_t WS_GDEC = 1024 * 1024;
constexpr size_t WS_UN = 1536 * 1024;
constexpr size_t WS_NST = 2048 * 1024;
constexpr size_t WS_BAR = 3072 * 1024;
constexpr size_t WS_WIN = 4 * MiB;
constexpr size_t WS_QKM = 4 * MiB;
constexpr size_t WS_WOUT = 36 * MiB;
constexpr size_t WS_WGU = 44 * MiB;
constexpr size_t WS_WD = 88 * MiB;
constexpr size_t WS_XN = 110 * MiB;
constexpr size_t WS_ATTO = 110 * MiB;
constexpr size_t WS_PROJ = 174 * MiB;
constexpr size_t WS_ACT = 174 * MiB;
constexpr size_t WS_CT = 366 * MiB;
constexpr size_t WS_CAT = 430 * MiB;
constexpr size_t WS_TAB = 494 * MiB;
constexpr size_t WS_END = 498 * MiB;

constexpr int LDS_BYTES = 147456;
#define LAS __attribute__((address_space(3)))
typedef unsigned short bf16;
typedef float f32x4 __attribute__((ext_vector_type(4)));
typedef unsigned u32x4 __attribute__((ext_vector_type(4)));
typedef unsigned u32x2 __attribute__((ext_vector_type(2)));
typedef short bf16x8 __attribute__((ext_vector_type(8)));
#define LDS_WAIT() asm volatile("s_waitcnt lgkmcnt(0)" ::: "memory")

__device__ __forceinline__ float bf2f(unsigned h) { return __uint_as_float(h << 16); }
__device__ __forceinline__ unsigned pk2(float lo, float hi) { return pg8::cvt_pk_bf16(lo, hi); }
__device__ __forceinline__ float wave_sum(float v) {
#pragma unroll
    for (int o = 1; o < 64; o <<= 1) v += __shfl_xor(v, o);
    return v;
}
__device__ __forceinline__ float sigmoidf_(float v) { return 1.0f / (1.0f + __expf(-v)); }

struct Args {
    const float* in[19]; float* out; unsigned char* ws; float inv[32]; int ph_lo, ph_hi;
};
struct Ctx { LAS unsigned char* lds; int tid, lane, wave, G, bid; unsigned char* ws; };

__device__ __forceinline__ void p0_transpose_item(const float* W, int K, int Nsrc, int src_col0, bf16* WT, int dst_row0, int kb, LAS float* scr, int lane, bool perm = false) {
    const int k0 = 64 * kb, c4 = lane & 15, kr = lane >> 4;
    f32x4 v[16];
#pragma unroll
    for (int i = 0; i < 16; ++i) v[i] = *(const f32x4*)(W + (size_t)(k0 + 4 * i + kr) * Nsrc + src_col0 + 4 * c4);
#pragma unroll
    for (int i = 0; i < 16; ++i) { LAS float* d = scr + (4 * i + kr) * 65 + 4 * c4; d[0] = v[i].x; d[1] = v[i].y; d[2] = v[i].z; d[3] = v[i].w; }
    LDS_WAIT(); asm volatile("" ::: "memory");
    const int c = lane & 7;
#pragma unroll
    for (int j = 0; j < 8; ++j) { const int n = (lane >> 3) + 8 * j, sc = perm ? ((n >> 1) + 32 * (n & 1)) : n; const LAS float* p = scr + (8 * c) * 65 + sc;
        u32x4 o; o.x = pk2(p[0 * 65], p[1 * 65]); o.y = pk2(p[2 * 65], p[3 * 65]); o.z = pk2(p[4 * 65], p[5 * 65]); o.w = pk2(p[6 * 65], p[7 * 65]);
        *(u32x4*)(WT + (size_t)(dst_row0 + n) * K + k0 + 8 * c) = o; }
    LDS_WAIT(); asm volatile("" ::: "memory");
}
template <int PART  > __device__ __forceinline__ void p0_weights(const Ctx& C, const float* w_in, const float* w_out, const float* w_gate, const float* w_up, const float* w_down) {
    LAS float* scr = (LAS float*)(C.lds + C.wave * 16640);
    const int gw = C.bid * 8 + C.wave, NGW = C.G * 8;
    constexpr int I_IN = 32 * 96, I_OUT = 32 * 32, I_G = 32 * 88, I_D = 88 * 32;
    constexpr int NITEMS = I_IN + I_OUT + 2 * I_G + I_D;
    bf16* WinT = (bf16*)(C.ws + WS_WIN); bf16* WoutT = (bf16*)(C.ws + WS_WOUT); bf16* WguT = (bf16*)(C.ws + WS_WGU); bf16* WdT = (bf16*)(C.ws + WS_WD);
    constexpr int IT_LO = PART == 0 ? 0 : I_IN, IT_HI = PART == 0 ? I_IN : NITEMS;
    for (int it = IT_LO + gw; it < IT_HI; it += NGW) {
        int r = it;
        if (r < I_IN) { const int kb = r / 96, nb = r % 96, n0 = 64 * nb; const bool rp = (n0 >= 3072 && n0 < 5120);
            p0_transpose_item(w_in, DM, 6152, n0 + (n0 >= 3072 ? 8 : 0), WinT, n0, kb, scr, C.lane, rp); continue; } r -= I_IN;
        if (r < I_OUT) { const int kb = r / 32, nb = r % 32; p0_transpose_item(w_out, DM, DM, 64 * nb, WoutT, 64 * nb, kb, scr, C.lane); continue; } r -= I_OUT;
        if (r < I_G) { const int kb = r / 88, nb = r % 88, n0 = 64 * nb; p0_transpose_item(w_gate, DM, FF, n0, WguT, (n0 >> 7) * 256 + (n0 & 127), kb, scr, C.lane); continue; } r -= I_G;
        if (r < I_G) { const int kb = r / 88, nb = r % 88, n0 = 64 * nb; p0_transpose_item(w_up, DM, FF, n0, WguT, (n0 >> 7) * 256 + 128 + (n0 & 127), kb, scr, C.lane); continue; } r -= I_G;
        { const int kb = r / 32, nb = r % 32; p0_transpose_item(w_down, FF, DM, 64 * nb, WdT, 64 * nb, kb, scr, C.lane); }
    }
}
template <int MODE> __device__ __forceinline__ void rows_pass(const Ctx& C, const float* src, const float* g, bf16* dst_bf, float* dst_f, const LAS float* wg, const float* b_ig = nullptr, const float* b_fg = nullptr, const bf16* add_bf = nullptr, const bf16* add2_bf = nullptr) {
    const int gw = C.bid * 8 + C.wave, NGW = C.G * 8, lane = C.lane;
    for (int m = gw; m < M; m += NGW) {
        const f32x4* xr = (const f32x4*)(src + (size_t)m * DM) + lane;
        f32x4 v[8]; float ss = 0.f;
#pragma unroll
        for (int j = 0; j < 8; ++j) v[j] = xr[64 * j];
        if (MODE != 0) { const u32x2* ar = (const u32x2*)(add_bf + (size_t)m * DM) + lane;
#pragma unroll
            for (int j = 0; j < 8; ++j) { const u32x2 a = ar[64 * j]; v[j].x += bf2f(a.x & 0xffffu); v[j].y += bf2f(a.x >> 16); v[j].z += bf2f(a.y & 0xffffu); v[j].w += bf2f(a.y >> 16); }
            if (MODE == 2) { const u32x2* ar2 = (const u32x2*)(add2_bf + (size_t)m * DM) + lane;
#pragma unroll
                for (int j = 0; j < 8; ++j) { const u32x2 a = ar2[64 * j]; v[j].x += bf2f(a.x & 0xffffu); v[j].y += bf2f(a.x >> 16); v[j].z += bf2f(a.y & 0xffffu); v[j].w += bf2f(a.y >> 16); } } }
#pragma unroll
        for (int j = 0; j < 8; ++j) ss += (v[j].x * v[j].x + v[j].y * v[j].y) + (v[j].z * v[j].z + v[j].w * v[j].w);
        const float rs = 1.0f / sqrtf(wave_sum(ss) * (1.0f / DM) + EPS);
#pragma unroll
        for (int j = 0; j < 8; ++j) { const f32x4 gg = ((const f32x4*)g)[64 * j + lane]; v[j] = v[j] * rs * gg; }
        if (MODE == 2) {
            f32x4* o = (f32x4*)(dst_f + (size_t)m * DM) + lane;
#pragma unroll
            for (int j = 0; j < 8; ++j) o[64 * j] = v[j];
        } else {
            u32x2* o = (u32x2*)(dst_bf + (size_t)m * DM) + lane;
#pragma unroll
            for (int j = 0; j < 8; ++j) { u32x2 w; w.x = pk2(v[j].x, v[j].y); w.y = pk2(v[j].z, v[j].w); o[64 * j] = w; }
        }
        if (MODE == 0) {
            float ga[8];
#pragma unroll
            for (int q = 0; q < 8; ++q) { float a = 0.f;
#pragma unroll
                for (int j = 0; j < 8; ++j) { const f32x4 w = ((const LAS f32x4*)(wg + q * DM))[64 * j + lane]; a += (v[j].x * w.x + v[j].y * w.y) + (v[j].z * w.z + v[j].w * w.w); }
                ga[q] = wave_sum(a); }
            float mine = ga[0];
#pragma unroll
            for (int q = 1; q < 8; ++q) mine = (lane == q) ? ga[q] : mine;
            if (lane < 8) { const int hh = lane & 3; const float pre = mine + (lane < 4 ? b_ig[hh] : b_fg[hh]); const float cp = 15.0f * tanhf(pre * (1.0f / 15.0f));
                if (lane < 4) ((float*)(C.ws + WS_IG))[hh * M + m] = cp; else ((float*)(C.ws + WS_LOGF))[hh * M + m] = fminf(cp, 0.f) - log1pf(expf(-fabsf(cp))); }
        }
    }
}

namespace ml {
constexpr int VTS = 72, QKS = 136;
__device__ __forceinline__ float incl_scan64(float v, int lane) {
#pragma unroll
    for (int off = 1; off < 64; off <<= 1) { const float n = __shfl_up(v, off); if (lane >= off) v += n; }
    return v;
}
template <int NR> __device__ __forceinline__ void conv_rows(const bf16* PROJ, const float* conv_w, const float* conv_b, int chb, int trow0, float scale, float (&y)[NR][8]) {
    u32x4 xr[NR + 3];
#pragma unroll
    for (int k = 0; k < NR + 3; ++k) { const int t = trow0 - 3 + k; xr[k] = (t >= 0) ? *(const u32x4*)(PROJ + (size_t)t * NPROJ + chb) : (u32x4){0u, 0u, 0u, 0u}; }
    float cw[4][8], cb[8];
#pragma unroll
    for (int j = 0; j < 4; ++j) { const f32x4 a = *(const f32x4*)(conv_w + j * 1024 + chb), b = *(const f32x4*)(conv_w + j * 1024 + chb + 4);
        cw[j][0] = a.x; cw[j][1] = a.y; cw[j][2] = a.z; cw[j][3] = a.w; cw[j][4] = b.x; cw[j][5] = b.y; cw[j][6] = b.z; cw[j][7] = b.w; }
    { const f32x4 a = *(const f32x4*)(conv_b + chb), b = *(const f32x4*)(conv_b + chb + 4); cb[0] = a.x; cb[1] = a.y; cb[2] = a.z; cb[3] = a.w; cb[4] = b.x; cb[5] = b.y; cb[6] = b.z; cb[7] = b.w; }
#pragma unroll
    for (int r = 0; r < NR; ++r)
#pragma unroll
        for (int c = 0; c < 8; ++c) { float a = cb[c];
#pragma unroll
            for (int j = 0; j < 4; ++j) { const unsigned w = xr[r + j][c >> 1]; a += cw[j][c] * ((c & 1) ? bf2f(w >> 16) : bf2f(w & 0xffffu)); }
            y[r][c] = a * sigmoidf_(a) * scale; }
}
__device__ __forceinline__ void stage_vt(LAS bf16* VT, const bf16* PROJ, int row0, int col0, int wave, int lane) {
#pragma unroll
    for (int i = 0; i < 4; ++i) { const int ec = wave + 8 * i;
        const u32x4 v = *(const u32x4*)(PROJ + (size_t)(row0 + lane) * NPROJ + col0 + 8 * ec);
        LAS bf16* d = VT + (8 * ec) * VTS + lane;
        d[0 * VTS] = (bf16)(v.x & 0xffffu); d[1 * VTS] = (bf16)(v.x >> 16); d[2 * VTS] = (bf16)(v.y & 0xffffu); d[3 * VTS] = (bf16)(v.y >> 16);
        d[4 * VTS] = (bf16)(v.z & 0xffffu); d[5 * VTS] = (bf16)(v.z >> 16); d[6 * VTS] = (bf16)(v.w & 0xffffu); d[7 * VTS] = (bf16)(v.w >> 16); }
}
__device__ __forceinline__ void m1_phase(const Ctx& C, float* U, const float* conv_w, const float* conv_b) {
    const bf16* PROJ = (const bf16*)(C.ws + WS_PROJ);
    const float* LOGF = (const float*)(C.ws + WS_LOGF); const float* IG = (const float*)(C.ws + WS_IG);
    float* GDEC = (float*)(C.ws + WS_GDEC); float* UN = (float*)(C.ws + WS_UN);
    LAS bf16* VT = (LAS bf16*)C.lds; LAS bf16* KwT = (LAS bf16*)(C.lds + 36864); LAS float* wv = (LAS float*)(C.lds + 55296);
    const int lane = C.lane, wave = C.wave, fr = lane & 15, fq = lane >> 4;
    for (int unit = C.bid; unit < MH * NCH; unit += C.G) {
        const int h = unit >> 8, c = unit & 255, row0 = c * CH;
        if (wave == 0) { const float lf = LOGF[h * M + row0 + lane], ig = IG[h * M + row0 + lane]; const float b = incl_scan64(lf, lane); const float bl = __shfl(b, 63);
            wv[lane] = __expf(bl - b + ig); if (lane == 63) GDEC[unit] = __expf(bl); }
        const int cg = C.tid & 15, rgrp = C.tid >> 4; float y[2][8];
        conv_rows<2>(PROJ, conv_w, conv_b, 512 + h * DQK + 8 * cg, row0 + 2 * rgrp, 1.0f, y);
        stage_vt(VT, PROJ, row0, PC_MV + h * DV, wave, lane);
        __syncthreads();
        {
#pragma unroll
          for (int r = 0; r < 2; ++r) { const int sidx = 2 * rgrp + r; const float w = wv[sidx];
#pragma unroll
            for (int c = 0; c < 8; ++c) KwT[(8 * cg + c) * VTS + sidx] = (bf16)(pk2(y[r][c] * w, 0.f) & 0xffffu); } }
        __syncthreads();
        if (C.tid < DQK) { float s = 0.f;
#pragma unroll
            for (int j = 0; j < 64; ++j) s += bf2f(KwT[C.tid * VTS + j]);
            UN[unit * DQK + C.tid] = s; }
        f32x4 acc[2][8];
#pragma unroll
        for (int i = 0; i < 2; ++i)
#pragma unroll
            for (int dt = 0; dt < 8; ++dt) acc[i][dt] = (f32x4){0.f, 0.f, 0.f, 0.f};
        bf16x8 a[2][2];
#pragma unroll
        for (int i = 0; i < 2; ++i)
#pragma unroll
            for (int ks = 0; ks < 2; ++ks) a[i][ks] = *(const LAS bf16x8*)(VT + ((2 * wave + i) * 16 + fr) * VTS + 32 * ks + 8 * fq);
#pragma unroll
        for (int dt = 0; dt < 8; ++dt)
#pragma unroll
            for (int ks = 0; ks < 2; ++ks) { const bf16x8 b = *(const LAS bf16x8*)(KwT + (dt * 16 + fr) * VTS + 32 * ks + 8 * fq);
#pragma unroll
                for (int i = 0; i < 2; ++i) acc[i][dt] = __builtin_amdgcn_mfma_f32_16x16x32_bf16(a[i][ks], b, acc[i][dt], 0, 0, 0); }
        float* Uu = U + (size_t)unit * (DV * DQK);
#pragma unroll
        for (int i = 0; i < 2; ++i)
#pragma unroll
            for (int dt = 0; dt < 8; ++dt)
#pragma unroll
                for (int j = 0; j < 4; ++j) Uu[((2 * wave + i) * 16 + 4 * fq + j) * DQK + dt * 16 + fr] = acc[i][dt][j];
        __syncthreads();
    }
}
__device__ __forceinline__ void m2_scan(const Ctx& C, const float* U) {
    const float* GDEC = (const float*)(C.ws + WS_GDEC); const float* UN = (const float*)(C.ws + WS_UN); float* NST = (float*)(C.ws + WS_NST);
    bf16* CT = (bf16*)(C.ws + WS_CT);
    const int gtid = C.bid * 512 + C.tid, GT = C.G * 512;
    for (int e = gtid; e < MH * DV * DQK; e += GT) {
        const int h = e >> 15, idx = e & 32767; float st = 0.f;
        for (int c0 = 0; c0 < NCH; c0 += 32) {
            float u[32], g[32];
#pragma unroll
            for (int k = 0; k < 32; ++k) { const int unit = h * NCH + c0 + k; u[k] = U[(size_t)unit * (DV * DQK) + idx]; g[k] = GDEC[unit]; }
#pragma unroll
            for (int k = 0; k < 32; ++k) { const int unit = h * NCH + c0 + k; CT[(size_t)unit * (DV * DQK) + idx] = (bf16)(pk2(st, 0.f) & 0xffffu); st = g[k] * st + u[k]; }
        }
    }
    { const int e = (C.G - 1 - C.bid) * 2 + (C.tid >> 8), lsel = C.tid & 255;
      if (lsel == 0 && e < MH * DQK) { const int h = e >> 7, d = e & 127; float st = 0.f;
        for (int c0 = 0; c0 < NCH; c0 += 32) { float u[32], g[32];
#pragma unroll
            for (int k = 0; k < 32; ++k) { const int unit = h * NCH + c0 + k; u[k] = UN[unit * DQK + d]; g[k] = GDEC[unit]; }
#pragma unroll
            for (int k = 0; k < 32; ++k) { const int unit = h * NCH + c0 + k; NST[unit * DQK + d] = st; st = g[k] * st + u[k]; } } } }
}
__device__ __forceinline__ void m3_phase(const Ctx& C, const float* mnorm_g, const float* conv_w, const float* conv_b) {
    const bf16* PROJ = (const bf16*)(C.ws + WS_PROJ);
    const float* LOGF = (const float*)(C.ws + WS_LOGF); const float* IG = (const float*)(C.ws + WS_IG); const float* NST = (const float*)(C.ws + WS_NST);
    const bf16* CT = (const bf16*)(C.ws + WS_CT); bf16* CAT = (bf16*)(C.ws + WS_CAT);
    LAS bf16* Qs = (LAS bf16*)C.lds; LAS bf16* Ks = (LAS bf16*)(C.lds + 17408); LAS bf16* VT = (LAS bf16*)(C.lds + 34816); LAS bf16* P = (LAS bf16*)(C.lds + 71680);
    LAS float* bv = (LAS float*)(C.lds + 80896); LAS float* igv = bv + 64; LAS float* eb = bv + 128; LAS float* den = bv + 192; LAS float* nv = bv + 256;
    LAS float* Hb = (LAS float*)C.lds;
    const int lane = C.lane, wave = C.wave, tid = C.tid, fr = lane & 15, fq = lane >> 4;
    for (int unit = C.bid; unit < MH * NCH; unit += C.G) {
        const int h = unit >> 8, c = unit & 255, row0 = c * CH;
        if (wave == 0) { const float lf = LOGF[h * M + row0 + lane], ig = IG[h * M + row0 + lane]; const float b = incl_scan64(lf, lane);
            bv[lane] = b; igv[lane] = ig; eb[lane] = __expf(b); den[lane] = 0.f; }
        if (wave == 1) { nv[lane] = NST[unit * DQK + lane]; nv[lane + 64] = NST[unit * DQK + 64 + lane]; }
        bf16x8 ctf[4][2]; u32x2 mov[8];
        { const bf16* CTu = CT + (size_t)unit * (DV * DQK);
#pragma unroll
          for (int ks = 0; ks < 4; ++ks)
#pragma unroll
            for (int ci = 0; ci < 2; ++ci) ctf[ks][ci] = *(const bf16x8*)(CTu + ((2 * wave + ci) * 16 + fr) * DQK + 32 * ks + 8 * fq);
#pragma unroll
          for (int i = 0; i < 8; ++i) mov[i] = *(const u32x2*)(PROJ + (size_t)(row0 + 8 * wave + i) * NPROJ + PC_MO + h * DV + 4 * lane); }
        const f32x4 gmn = *(const f32x4*)(mnorm_g + h * DV + 4 * lane);
        { const int tens = tid >> 8, rgrp = (tid >> 4) & 15, cg = tid & 15; float y[4][8];
          conv_rows<4>(PROJ, conv_w, conv_b, tens * 512 + h * DQK + 8 * cg, row0 + 4 * rgrp, tens ? 1.0f : 0.08838834764831845f, y);
          LAS bf16* dst = tens ? Ks : Qs;
#pragma unroll
          for (int r = 0; r < 4; ++r) *(LAS u32x4*)(dst + (4 * rgrp + r) * QKS + 8 * cg) = (u32x4){pk2(y[r][0], y[r][1]), pk2(y[r][2], y[r][3]), pk2(y[r][4], y[r][5]), pk2(y[r][6], y[r][7])}; }
        stage_vt(VT, PROJ, row0, PC_MV + h * DV, wave, lane);
        __syncthreads();
        { const int tr = wave >> 1;
#pragma unroll
          for (int cc = 0; cc < 2; ++cc) { const int tc = 2 * (wave & 1) + cc; const int s = tc * 16 + fr;
            if (tc <= tr) {
                f32x4 acc = (f32x4){0.f, 0.f, 0.f, 0.f};
#pragma unroll
                for (int ks = 0; ks < 4; ++ks) { const bf16x8 a = *(const LAS bf16x8*)(Qs + (tr * 16 + fr) * QKS + 32 * ks + 8 * fq), b = *(const LAS bf16x8*)(Ks + (tc * 16 + fr) * QKS + 32 * ks + 8 * fq);
                    acc = __builtin_amdgcn_mfma_f32_16x16x32_bf16(a, b, acc, 0, 0, 0); }
                const float bs = bv[s], is = igv[s];
#pragma unroll
                for (int j = 0; j < 4; ++j) { const int t = tr * 16 + 4 * fq + j; float p = (s <= t) ? acc[j] * __expf(bv[t] - bs + is) : 0.f;
                    P[t * VTS + s] = (bf16)(pk2(p, 0.f) & 0xffffu);
                    p += __shfl_xor(p, 1); p += __shfl_xor(p, 2); p += __shfl_xor(p, 4); p += __shfl_xor(p, 8);
                    if (fr == 0) unsafeAtomicAdd((float*)&den[t], p); }
            } else {
#pragma unroll
                for (int j = 0; j < 4; ++j) P[(tr * 16 + 4 * fq + j) * VTS + s] = (bf16)0;
            } } }
        { const int t = tid >> 3, part = tid & 7; float s = 0.f;
#pragma unroll
          for (int d = 0; d < 16; ++d) s += bf2f(Qs[t * QKS + 16 * part + d]) * nv[16 * part + d];
          s += __shfl_xor(s, 1); s += __shfl_xor(s, 2); s += __shfl_xor(s, 4);
          if (part == 0) unsafeAtomicAdd((float*)&den[t], eb[t] * s); }
        __syncthreads();
        f32x4 hv[4][2];
        { f32x4 accI[4][2], accP[4][2];
#pragma unroll
          for (int rt = 0; rt < 4; ++rt)
#pragma unroll
            for (int ci = 0; ci < 2; ++ci) { accI[rt][ci] = (f32x4){0.f, 0.f, 0.f, 0.f}; accP[rt][ci] = (f32x4){0.f, 0.f, 0.f, 0.f}; }
#pragma unroll
          for (int ks = 0; ks < 4; ++ks) {
#pragma unroll
            for (int rt = 0; rt < 4; ++rt) { const bf16x8 a = *(const LAS bf16x8*)(Qs + (rt * 16 + fr) * QKS + 32 * ks + 8 * fq);
#pragma unroll
                for (int ci = 0; ci < 2; ++ci) accI[rt][ci] = __builtin_amdgcn_mfma_f32_16x16x32_bf16(a, ctf[ks][ci], accI[rt][ci], 0, 0, 0); } }
#pragma unroll
          for (int ks = 0; ks < 2; ++ks) { bf16x8 b[2];
#pragma unroll
            for (int ci = 0; ci < 2; ++ci) b[ci] = *(const LAS bf16x8*)(VT + ((2 * wave + ci) * 16 + fr) * VTS + 32 * ks + 8 * fq);
#pragma unroll
            for (int rt = 0; rt < 4; ++rt) { const bf16x8 a = *(const LAS bf16x8*)(P + (rt * 16 + fr) * VTS + 32 * ks + 8 * fq);
#pragma unroll
                for (int ci = 0; ci < 2; ++ci) accP[rt][ci] = __builtin_amdgcn_mfma_f32_16x16x32_bf16(a, b[ci], accP[rt][ci], 0, 0, 0); } }
#pragma unroll
          for (int rt = 0; rt < 4; ++rt)
#pragma unroll
            for (int j = 0; j < 4; ++j) { const int t = rt * 16 + 4 * fq + j; const float e = eb[t], dn = 1.0f / fmaxf(fabsf(den[t]), 1.0f);
#pragma unroll
                for (int ci = 0; ci < 2; ++ci) hv[rt][ci][j] = (e * accI[rt][ci][j] + accP[rt][ci][j]) * dn; } }
        __syncthreads();
#pragma unroll
        for (int rt = 0; rt < 4; ++rt)
#pragma unroll
            for (int ci = 0; ci < 2; ++ci)
#pragma unroll
                for (int j = 0; j < 4; ++j) Hb[(rt * 16 + 4 * fq + j) * 260 + (2 * wave + ci) * 16 + fr] = hv[rt][ci][j];
        __syncthreads();
#pragma unroll
        for (int i = 0; i < 8; ++i) { const int t = 8 * wave + i;
            const f32x4 v = *(const LAS f32x4*)(Hb + t * 260 + 4 * lane);
            const float ss = wave_sum((v.x * v.x + v.y * v.y) + (v.z * v.z + v.w * v.w));
            const float rs = 1.0f / sqrtf(ss * (1.0f / DV) + EPS);
            const f32x4 g = gmn; const u32x2 mo = mov[i];
            const float o0 = v.x * rs * g.x * sigmoidf_(bf2f(mo.x & 0xffffu)), o1 = v.y * rs * g.y * sigmoidf_(bf2f(mo.x >> 16));
            const float o2 = v.z * rs * g.z * sigmoidf_(bf2f(mo.y & 0xffffu)), o3 = v.w * rs * g.w * sigmoidf_(bf2f(mo.y >> 16));
            u32x2 w; w.x = pk2(o0, o1); w.y = pk2(o2, o3);
            *(u32x2*)(CAT + (size_t)(row0 + t) * DM + h * DV + 4 * lane) = w; }
        __syncthreads();
    }
}
}

__device__ __forceinline__ void attn_combine(const Ctx& C, const Args& A) {
    const bf16* AO = (const bf16*)(C.ws + WS_ATTO); bf16* CAT = (bf16*)(C.ws + WS_CAT);
    const int lane = C.lane;
    const float l1 = wave_sum(A.in[8][lane] * A.in[9][lane]), l2 = wave_sum(A.in[10][lane] * A.in[11][lane]);
    const float lam = expf(l1) - expf(l2) + LAM_INIT;
    const int h = lane >> 3, part = lane & 7;
    float g[16];
#pragma unroll
    for (int q = 0; q < 4; ++q) { const f32x4 t = *(const f32x4*)(A.in[12] + 16 * part + 4 * q); g[4 * q] = t.x * (1.0f - LAM_INIT); g[4 * q + 1] = t.y * (1.0f - LAM_INIT); g[4 * q + 2] = t.z * (1.0f - LAM_INIT); g[4 * q + 3] = t.w * (1.0f - LAM_INIT); }
    const int gw = C.bid * 8 + C.wave, NGW = C.G * 8;
    for (int t0 = gw; t0 < M; t0 += 2 * NGW) {
        u32x4 a[2][2], b[2][2];
#pragma unroll
        for (int rr = 0; rr < 2; ++rr) { const int t = t0 + rr * NGW; if (t < M) { const bf16* p = AO + (size_t)t * DM + h * 256 + 16 * part;
            a[rr][0] = *(const u32x4*)p; a[rr][1] = *(const u32x4*)(p + 8); b[rr][0] = *(const u32x4*)(p + 128); b[rr][1] = *(const u32x4*)(p + 136); } }
#pragma unroll
        for (int rr = 0; rr < 2; ++rr) { const int t = t0 + rr * NGW; if (t < M) {
            float d[16]; float ss = 0.f;
#pragma unroll
            for (int q = 0; q < 2; ++q)
#pragma unroll
                for (int k = 0; k < 4; ++k) { const unsigned wa = a[rr][q][k], wb = b[rr][q][k];
                    const float d0 = bf2f(wa & 0xffffu) - lam * bf2f(wb & 0xffffu), d1 = bf2f(wa >> 16) - lam * bf2f(wb >> 16);
                    d[8 * q + 2 * k] = d0; d[8 * q + 2 * k + 1] = d1; ss += d0 * d0 + d1 * d1; }
            ss += __shfl_xor(ss, 1); ss += __shfl_xor(ss, 2); ss += __shfl_xor(ss, 4);
            const float rs = 1.0f / sqrtf(ss * (1.0f / 128.0f) + EPS);
            u32x4 o0, o1;
#pragma unroll
            for (int k = 0; k < 4; ++k) { o0[k] = pk2(d[2 * k] * rs * g[2 * k], d[2 * k + 1] * rs * g[2 * k + 1]); o1[k] = pk2(d[8 + 2 * k] * rs * g[8 + 2 * k], d[9 + 2 * k] * rs * g[9 + 2 * k]); }
            bf16* q = CAT + (size_t)t * DM + 1024 + h * 128 + 16 * part; *(u32x4*)q = o0; *(u32x4*)(q + 8) = o1; } }
    }
}

#define XB_TMO      128
#define XB_XCNT(j)  (256  + 64 * (j))
#define XB_XSUB(j)  (1280 + 64 * (j))
#define XB_XGEN(j)  (2304 + 64 * (j))
#define XB_TOP      3328
#define XB_TOPGEN   3392
#define XCD_BAR_WORDS 3456
#define XB_SPIN_CAP (1u << 18)

__device__ __forceinline__ unsigned xb_ld(unsigned* p)              { return __hip_atomic_load(p, __ATOMIC_RELAXED, __HIP_MEMORY_SCOPE_AGENT); }
__device__ __forceinline__ unsigned xb_add(unsigned* p, unsigned v) { return __hip_atomic_fetch_add(p, v, __ATOMIC_RELAXED, __HIP_MEMORY_SCOPE_AGENT); }
__device__ __forceinline__ unsigned xb_xcc_id() { return (unsigned)__builtin_amdgcn_s_getreg((3 << 11) | 20) & 0xFu; }
#define XB_SPIN(cond, bar) do { unsigned _sp = 0; while (cond) { __builtin_amdgcn_s_sleep(1); \
    if ((++_sp & 255u) == 0u) { if (xb_ld(&(bar)[XB_TMO])) break; if (_sp > XB_SPIN_CAP) { atomicAdd(&(bar)[XB_TMO], 1u); break; } } } } while (0)

struct XcdBarrier {
    unsigned* bar; unsigned x;
    volatile LAS unsigned* st;
};

__device__ __forceinline__ XcdBarrier xcd_barrier_post(unsigned* bar, volatile LAS unsigned* st) {
    XcdBarrier b; b.bar = bar; b.x = xb_xcc_id(); b.st = st;
    if (threadIdx.x == 0) (void)xb_add(&bar[XB_XCNT(b.x)], 1u);
    return b;
}
__device__ __forceinline__ void xcd_barrier_complete(unsigned* bar, unsigned x, unsigned& nloc, unsigned& nx) {
    const unsigned G = gridDim.x * gridDim.y * gridDim.z;
    unsigned sum, cnt, mine, sp = 0u;
    for (;;) {
        sum = 0u; cnt = 0u; mine = 0u;
#pragma unroll
        for (unsigned j = 0; j < 16; ++j) { const unsigned c = xb_ld(&bar[XB_XCNT(j)]); sum += c; cnt += (c > 0u) ? 1u : 0u; mine = (j == x) ? c : mine; }
        if (sum == G) break;
        __builtin_amdgcn_s_sleep(1);
        if ((++sp & 255u) == 0u) { if (xb_ld(&bar[XB_TMO])) break; if (sp > XB_SPIN_CAP) { atomicAdd(&bar[XB_TMO], 1u); break; } }
    }
    nloc = mine > 0u ? mine : 1u; nx = cnt > 0u ? cnt : 1u;
}

__device__ __forceinline__ void xcd_barrier(const XcdBarrier& b) {
    asm volatile("s_waitcnt vmcnt(0)" ::: "memory");
    __syncthreads();
    if (threadIdx.x == 0) {
        unsigned* bar = b.bar;
        __builtin_amdgcn_s_waitcnt(0);
        unsigned nloc = b.st[0], nx = b.st[1];
        if (nloc == 0u) { xcd_barrier_complete(bar, b.x, nloc, nx); b.st[0] = nloc; b.st[1] = nx; }
        const unsigned old = xb_add(&bar[XB_XSUB(b.x)], 1u);
        const unsigned gen = old / nloc;
        if (old + 1u == (gen + 1u) * nloc) {
            __builtin_amdgcn_fence(__ATOMIC_RELEASE, "agent");
            asm volatile("s_waitcnt vmcnt(0)" ::: "memory");
            const unsigned og = xb_add(&bar[XB_TOP], 1u);
            const unsigned tg = og / nx;
            if (og + 1u == (tg + 1u) * nx) xb_add(&bar[XB_TOPGEN], 1u);
            else XB_SPIN(xb_ld(&bar[XB_TOPGEN]) == tg, bar);
            __builtin_amdgcn_fence(__ATOMIC_ACQUIRE, "agent");
            xb_add(&bar[XB_XGEN(b.x)], 1u);
            asm volatile("s_waitcnt vmcnt(0)" ::: "memory");
        } else {
            XB_SPIN(xb_ld(&bar[XB_XGEN(b.x)]) == gen, bar);
            __builtin_amdgcn_fence(__ATOMIC_ACQUIRE, "agent");
            asm volatile("s_waitcnt vmcnt(0)" ::: "memory");
        }
    }
    __syncthreads();
}

__global__ void __launch_bounds__(512, 2) fwd_megakernel(Args args) {
    __builtin_assume(__builtin_amdgcn_workitem_id_y() == 0); __builtin_assume(__builtin_amdgcn_workitem_id_z() == 0);
    extern __shared__ __attribute__((aligned(16))) unsigned char lds[];
    cg::grid_group grid = cg::this_grid();
#define MKCTX() Ctx C; { int t_ = threadIdx.x; asm volatile("" : "+v"(t_)); C.lds = (LAS unsigned char*)lds; C.tid = t_; C.lane = t_ & 63; C.wave = __builtin_amdgcn_readfirstlane(t_ >> 6); C.G = gridDim.x; C.bid = blockIdx.x; C.ws = args.ws; }
    unsigned char* const wsb = args.ws; const int G_ = gridDim.x, bid_ = blockIdx.x;
    const int lo = args.ph_lo, hi = args.ph_hi;
    volatile LAS unsigned* bst = (volatile LAS unsigned*)((LAS unsigned char*)lds + 147392);
    if (threadIdx.x < 16) bst[threadIdx.x] = 0u;
    __syncthreads();
    const XcdBarrier bar = xcd_barrier_post((unsigned*)(args.ws + WS_BAR), bst);
    if (hi > 1000) grid.sync();
#define IN(k) (lo <= (k) && (k) < hi)
#define SEAM(k) do { if (IN(k) && IN((k) + 1)) xcd_barrier(bar); } while (0)
    const float* x = args.in[0];
    bf16* XN = (bf16*)(wsb + WS_XN); bf16* PROJ = (bf16*)(wsb + WS_PROJ); bf16* CAT = (bf16*)(wsb + WS_CAT); bf16* ACT = (bf16*)(wsb + WS_ACT);

    if (IN(0)) { MKCTX();
        LAS float* wg = (LAS float*)C.lds;
        for (int i = C.tid; i < 8 * DM; i += 512) { const int k = i >> 3, q = i & 7; wg[q * DM + k] = args.in[2][(size_t)k * 6152 + 3072 + q]; }
        __syncthreads();
        rows_pass<0>(C, x, args.in[1], XN, nullptr, wg, args.in[5], args.in[6]);
        { float* TAB = (float*)(C.ws + WS_TAB);
          for (int i = C.bid * 512 + C.tid; i < M * 32; i += C.G * 512) { const int t = i >> 5, d = i & 31; const float ang = (float)t * args.inv[d];
              double rev = (double)ang * 0.15915494309189535; rev -= rint(rev); const float fr = (float)rev; TAB[2 * i] = __builtin_amdgcn_cosf(fr); TAB[2 * i + 1] = __builtin_amdgcn_sinf(fr); } }
        __syncthreads();
        p0_weights<0>(C, args.in[2], args.in[13], args.in[15], args.in[16], args.in[17]);
        __syncthreads();
    }
    SEAM(0);
    if (IN(1)) { MKCTX();
        pg8::Gemm g{XN, (const bf16*)(C.ws + WS_WIN), M, NPROJ, DM}; pg8::StaticOrder S; S.init(M, NPROJ, C.G, C.bid);
        pg8::EpiProj E{PROJ, NPROJ, (const float*)(C.ws + WS_TAB), 0.125f * 1.4426950408889634f};
        const int lateq = (C.bid >> 3) & 3;
        if (lateq == 0) { p0_weights<1>(C, args.in[2], args.in[13], args.in[15], args.in[16], args.in[17]); __syncthreads(); }
        pg8::gemm_phase<pg8::EpiProj, pg8::StaticOrder, PG8_ALIGN, PG8_SP2>(C.lds, g, S, E);
        if (lateq == 1) { __syncthreads(); p0_weights<1>(C, args.in[2], args.in[13], args.in[15], args.in[16], args.in[17]); __syncthreads(); }
    }
    SEAM(1);
    if (IN(2)) {
        const attn128::AttnTensors AT{(const attn128::bf16*)PROJ, (attn128::bf16*)(wsb + WS_ATTO)};
        const int lateq = (bid_ >> 3) & 3, m1q = ((bid_ >> 3) + 2) & 3;
        if (lateq == 2) { { MKCTX(); p0_weights<1>(C, args.in[2], args.in[13], args.in[15], args.in[16], args.in[17]); } __syncthreads(); }
        if (m1q == 0) { { MKCTX(); ml::m1_phase(C, args.out, args.in[3], args.in[4]); } __syncthreads(); }
        attn128::attn_phase<8>((char*)lds, AT, G_, bid_, 3, 3);
        if (m1q == 1) { __syncthreads(); { MKCTX(); ml::m1_phase(C, args.out, args.in[3], args.in[4]); } __syncthreads(); }
        attn128::attn_phase<8>((char*)lds, AT, G_, bid_, 2, 2);
        if (m1q == 2) { __syncthreads(); { MKCTX(); ml::m1_phase(C, args.out, args.in[3], args.in[4]); } __syncthreads(); }
        attn128::attn_phase<8>((char*)lds, AT, G_, bid_, 1, 0);
        if (m1q == 3) { __syncthreads(); { MKCTX(); ml::m1_phase(C, args.out, args.in[3], args.in[4]); } }
        if (lateq == 3) { __syncthreads(); { MKCTX(); p0_weights<1>(C, args.in[2], args.in[13], args.in[15], args.in[16], args.in[17]); } __syncthreads(); }
    }
    SEAM(2);
    if (IN(3)) { MKCTX(); ml::m2_scan(C, args.out); }
    SEAM(3);
    if (IN(4)) { { MKCTX(); ml::m3_phase(C, args.in[7], args.in[3], args.in[4]); } { MKCTX(); attn_combine(C, args); } }
    SEAM(4);
    if (IN(5)) { MKCTX();
        pg8::Gemm g{CAT, (const bf16*)(C.ws + WS_WOUT), M, DM, DM}; pg8::StaticOrder S; S.init(M, DM, C.G, C.bid);
        pg8::EpiBf16<0> E{(bf16*)(C.ws + WS_CT), DM, nullptr, 0, 0, 1.f};
        pg8::gemm_phase<pg8::EpiBf16<0>, pg8::StaticOrder, PG8_ALIGN, PG8_SP2>(C.lds, g, S, E);
    }
    SEAM(5);
    if (IN(6)) { MKCTX(); rows_pass<1>(C, x, args.in[14], XN, nullptr, nullptr, nullptr, nullptr, (const bf16*)(C.ws + WS_CT), nullptr); }
    SEAM(6);
    if (IN(7)) { MKCTX();
        pg8::Gemm g{XN, (const bf16*)(C.ws + WS_WGU), M, NGU, DM}; pg8::StaticOrder S; S.init(M, NGU, C.G, C.bid);
        pg8::EpiSwiGLU E{ACT, FF};
        pg8::gemm_phase<pg8::EpiSwiGLU, pg8::StaticOrder, PG8_ALIGN, PG8_SP2>(C.lds, g, S, E);
    }
    SEAM(7);
    if (IN(8)) { MKCTX();
        pg8::Gemm g{ACT, (const bf16*)(C.ws + WS_WD), M, DM, FF}; pg8::StaticOrder S; S.init(M, DM, C.G, C.bid);
        pg8::EpiBf16<0> E{CAT, DM, nullptr, 0, 0, 1.f};
        pg8::gemm_phase<pg8::EpiBf16<0>, pg8::StaticOrder, PG8_ALIGN, PG8_SP2>(C.lds, g, S, E);
    }
    SEAM(8);
    if (IN(9)) { MKCTX(); rows_pass<2>(C, x, args.in[18], nullptr, args.out, nullptr, nullptr, nullptr, (const bf16*)(C.ws + WS_CT), CAT); }
#undef IN
#undef SEAM
}

#ifndef MK_N_LAUNCHES
#define MK_N_LAUNCHES 1
#endif
extern "C" void kernel_launch(void* const* d_in, const int* in_sizes, int n_in, void* d_out, int out_size, void* d_ws, size_t ws_size, hipStream_t stream) {
    static int grid = 0;
    if (grid == 0) {
        if (n_in != 19 || in_sizes[0] != M * DM || out_size != M * DM || ws_size < WS_END) { fprintf(stderr, "kernel_launch: unexpected shapes: n_in %d in0 %d out %d ws %zu (need %zu); nothing launched\n", n_in, n_in > 0 ? in_sizes[0] : -1, out_size, ws_size, (size_t)WS_END); grid = -1; return; }
        int dev = 0, cus = 0, per_cu = 0;
        if (hipGetDevice(&dev) != hipSuccess || hipDeviceGetAttribute(&cus, hipDeviceAttributeMultiprocessorCount, dev) != hipSuccess) { grid = -1; return; }
        if (hipFuncSetAttribute((const void*)fwd_megakernel, hipFuncAttributeMaxDynamicSharedMemorySize, LDS_BYTES) != hipSuccess) { fprintf(stderr, "kernel_launch: hipFuncSetAttribute failed\n"); grid = -1; return; }
        if (hipOccupancyMaxActiveBlocksPerMultiprocessor(&per_cu, (const void*)fwd_megakernel, 512, LDS_BYTES) != hipSuccess || per_cu < 1) { fprintf(stderr, "kernel_launch: occupancy query says %d\n", per_cu); per_cu = 1; }
        (void)hipGetLastError();
        grid = cus * per_cu;
        fprintf(stderr, "kernel_launch: grid %d (cus %d x %d), ws %zu MiB\n", grid, cus, per_cu, ws_size >> 20);
    }
    if (grid < 0) return;
    Args a{};
    for (int i = 0; i < 19; ++i) a.in[i] = (const float*)d_in[i];
    a.out = (float*)d_out; a.ws = (unsigned char*)d_ws;
    for (int d = 0; d < 32; ++d) a.inv[d] = (float)pow(10000.0, -(double)d / 32.0);
    if (hipMemsetAsync((char*)d_ws + WS_BAR, 0, 16384, stream) != hipSuccess) { fprintf(stderr, "kernel_launch: memset of the barrier words failed\n"); return; }
    if (MK_N_LAUNCHES == 1) {
        a.ph_lo = 0; a.ph_hi = 10;
        void* kargs[] = {&a};
        hipError_t e = hipLaunchCooperativeKernel((const void*)fwd_megakernel, dim3(grid), dim3(512), kargs, LDS_BYTES, stream);
        if (e != hipSuccess) fprintf(stderr, "cooperative launch failed: %s (grid %d)\n", hipGetErrorString(e), grid);
    } else {
        for (int p = 0; p < 10; ++p) { a.ph_lo = p; a.ph_hi = p + 1; hipLaunchKernelGGL(fwd_megakernel, dim3(grid), dim3(512), LDS_BYTES, stream, a); }
    }
}
```

```cpp
#include <hip/hip_runtime.h>
#include <hip/hip_cooperative_groups.h>
#include <cstdio>
#include <cstdint>
#include <cmath>
namespace cg = cooperative_groups;
namespace pg8 {
#define PG8_LAS __attribute__((address_space(3)))
typedef unsigned short bf16_t;
typedef short bf16x8 __attribute__((ext_vector_type(8)));
typedef float f32x4 __attribute__((ext_vector_type(4)));
typedef unsigned u32x4 __attribute__((ext_vector_type(4)));
constexpr int BM = 256, BK = 64, HALF = 128, HTB = HALF * BK * 2  , STAGE_BYTES = 8 * HTB, NXCD = 8, WGM = 8;

__host__ __device__ __forceinline__ int lds_byte(int r, int c) { const int st = (r >> 4) * 2 + (c >> 5), rr = r & 15, cc = c & 31, ob = rr * 64 + cc * 2; return st * 1024 + (ob ^ (((ob >> 9) & 1) << 5)); }
__host__ __device__ __forceinline__ void stage_rc(int b, int& R, int& C) { const int st = b / 1024, sb = b % 1024, swz = sb ^ (((sb >> 9) & 1) << 5); R = (st >> 1) * 16 + swz / 64; C = (st & 1) * 32 + (swz % 64) / 2; }
__host__ __device__ __forceinline__ int perm32(int rho) { const int n = rho >> 4, i = rho & 15; return 8 * (i >> 2) + 4 * n + (i & 3); }

struct Unit { int pm, pn; };
struct Gemm { const bf16_t* A; const bf16_t* Bt; int M, N, K; };

struct StaticOrder {
    int nM, nN, nwg, G, c;
    __host__ __device__ void init(int M, int N, int G_, int c_) { nM = M / BM; nN = N / BM; nwg = nM * nN; G = G_; c = c_; }
    __host__ __device__ bool next(int i, Unit& u) const {
        const long L = (long)i * G + c; if (L >= nwg) return false;
        int wgid = (int)L; { const int q = nwg / NXCD, r = nwg % NXCD, xcd = wgid % NXCD, off = wgid / NXCD; wgid = (xcd < r ? xcd * (q + 1) : r * (q + 1) + (xcd - r) * q) + off; }
        const int nig = WGM * nN, gid = wgid / nig, fm = gid * WGM, gsz = (nM - fm) < WGM ? (nM - fm) : WGM;
        u.pm = fm + ((wgid % nig) % gsz); u.pn = (wgid % nig) / gsz; return true;
    }
    __device__ __forceinline__ void a_ready(const Unit&) const {}
    __device__ __forceinline__ void done(const Unit&) const {}
};

__device__ __forceinline__ unsigned cvt_pk_bf16(float lo, float hi) { unsigned r; asm volatile("v_cvt_pk_bf16_f32 %0, %1, %2" : "=v"(r) : "v"(lo), "v"(hi)); return r; }
typedef float f32x2 __attribute__((ext_vector_type(2)));
__device__ __forceinline__ f32x2 gelu_pk(f32x2 v) {
    const f32x2 av = __builtin_elementwise_abs(v), d = av * 0.2316418882f + 1.0f;
    f32x2 t; t.x = __builtin_amdgcn_rcpf(d.x); t.y = __builtin_amdgcn_rcpf(d.y);
    f32x2 q = t * 0.5307027145f + (-0.7265760135f); q = q * t + 0.7107068705f; q = q * t + (-0.142248368f); q = q * t + 0.127414796f; q = q * t;
    const f32x2 s = (v * v) * (-0.72134752044f);
    f32x2 e; e.x = __builtin_amdgcn_exp2f(s.x); e.y = __builtin_amdgcn_exp2f(s.y);
    const f32x2 m = v * (q * e), r = v - m;
    f32x2 o; o.x = v.x < 0.f ? m.x : r.x; o.y = v.y < 0.f ? m.y : r.y; return o;
}

template <int ACT  > struct EpiBf16 {
    static constexpr bool PERM = true, AFTER_DRAIN = false; static_assert(ACT == 0 || ACT == 1, "EpiBf16: ACT is 0 (none) or 1 (gelu_pk)");
    bf16_t* O; int ldc; const float* bias; int split_cols; size_t split_stride; float scale0;
    __device__ __forceinline__ void operator()(const f32x4 (&acc)[2][2][4][2], const Unit& u, int wr, int wc, int fr, int fq) const {
        const int row0 = u.pm * BM + wr * 64 + fr; int colt = u.pn * BM; bf16_t* base = O;
        float sc = 1.f; if (split_cols) { const int t = colt / split_cols; base += (size_t)t * split_stride; colt -= t * split_cols; if (t == 0) sc = scale0; }
        const int col0 = colt + wc * 32 + 8 * fq, bcol0 = u.pn * BM + wc * 32 + 8 * fq;
        f32x4 bv[2][2];
#pragma unroll
        for (int bj = 0; bj < 2; ++bj)
#pragma unroll
            for (int n = 0; n < 2; ++n) bv[bj][n] = bias ? *(const f32x4*)(bias + bcol0 + bj * HALF + 4 * n) : (f32x4){0.f, 0.f, 0.f, 0.f};
#pragma unroll
        for (int ai = 0; ai < 2; ++ai)
#pragma unroll
            for (int m = 0; m < 4; ++m) { bf16_t* rowp = base + (size_t)(row0 + ai * HALF + m * 16) * ldc + col0;
#pragma unroll
                for (int bj = 0; bj < 2; ++bj) { f32x4 v0 = acc[ai][bj][m][0] + bv[bj][0], v1 = acc[ai][bj][m][1] + bv[bj][1];
                    if (ACT == 1) { f32x2 a = gelu_pk((f32x2){v0[0], v0[1]}), b = gelu_pk((f32x2){v0[2], v0[3]}), c = gelu_pk((f32x2){v1[0], v1[1]}), d = gelu_pk((f32x2){v1[2], v1[3]});
                        v0 = (f32x4){a.x, a.y, b.x, b.y}; v1 = (f32x4){c.x, c.y, d.x, d.y}; }
                    v0 = v0 * sc; v1 = v1 * sc; u32x4 w; w.x = cvt_pk_bf16(v0[0], v0[1]); w.y = cvt_pk_bf16(v0[2], v0[3]); w.z = cvt_pk_bf16(v1[0], v1[1]); w.w = cvt_pk_bf16(v1[2], v1[3]);
                    *(u32x4*)(rowp + bj * HALF) = w; } }
    }
};
struct EpiProj {
    static constexpr bool PERM = true, AFTER_DRAIN = false;
    bf16_t* O; int ldc; const float* tab; float scale_q;
    __device__ __forceinline__ void operator()(const f32x4 (&acc)[2][2][4][2], const Unit& u, int wr, int wc, int fr, int fq) const {
        const int row0 = u.pm * BM + wr * 64 + fr, col0 = u.pn * BM + wc * 32 + 8 * fq;
        const bool rope = (u.pn >= 12 && u.pn < 20); const float sc = (u.pn >= 12 && u.pn < 16) ? scale_q : 1.0f;
        asm volatile("s_nop 15" ::: "memory");
#pragma unroll
        for (int ai = 0; ai < 2; ++ai)
#pragma unroll
            for (int m = 0; m < 4; ++m) { const int row = row0 + ai * HALF + m * 16; bf16_t* rowp = O + (size_t)row * ldc + col0;
#pragma unroll
                for (int bj = 0; bj < 2; ++bj) { f32x4 v0 = acc[ai][bj][m][0], v1 = acc[ai][bj][m][1];
                    if (rope) { const int dp = ((col0 + bj * HALF) & 63) >> 1;
                        const f32x4 cs0 = *(const f32x4*)(tab + ((size_t)row * 32 + dp) * 2), cs1 = *(const f32x4*)(tab + ((size_t)row * 32 + dp + 2) * 2);
                        const f32x4 a = v0, b = v1;
                        v0[0] = (a[0] * cs0[0] - a[1] * cs0[1]) * sc; v0[1] = (a[1] * cs0[0] + a[0] * cs0[1]) * sc; v0[2] = (a[2] * cs0[2] - a[3] * cs0[3]) * sc; v0[3] = (a[3] * cs0[2] + a[2] * cs0[3]) * sc;
                        v1[0] = (b[0] * cs1[0] - b[1] * cs1[1]) * sc; v1[1] = (b[1] * cs1[0] + b[0] * cs1[1]) * sc; v1[2] = (b[2] * cs1[2] - b[3] * cs1[3]) * sc; v1[3] = (b[3] * cs1[2] + b[2] * cs1[3]) * sc; }
                    u32x4 w; w.x = cvt_pk_bf16(v0[0], v0[1]); w.y = cvt_pk_bf16(v0[2], v0[3]); w.z = cvt_pk_bf16(v1[0], v1[1]); w.w = cvt_pk_bf16(v1[2], v1[3]);
                    *(u32x4*)(rowp + bj * HALF) = w; } }
    }
};
struct EpiResF32 {
    static constexpr bool PERM = false, AFTER_DRAIN = false;
    const float* base; float* out; int ldc;
    __device__ __forceinline__ void operator()(const f32x4 (&acc)[2][2][4][2], const Unit& u, int wr, int wc, int fr, int fq) const {
        const int row0 = u.pm * BM + wr * 64 + fr, col0 = u.pn * BM + wc * 32 + 4 * fq;
#pragma unroll
        for (int ai = 0; ai < 2; ++ai)
#pragma unroll
            for (int m = 0; m < 4; ++m) { const size_t off = (size_t)(row0 + ai * HALF + m * 16) * ldc + col0;
#pragma unroll
                for (int bj = 0; bj < 2; ++bj)
#pragma unroll
                    for (int n = 0; n < 2; ++n) { const f32x4 b = *(const f32x4*)(base + off + bj * HALF + n * 16); *(f32x4*)(out + off + bj * HALF + n * 16) = b + acc[ai][bj][m][n]; } }
    }
};
struct EpiSwiGLU {
    static constexpr bool PERM = true, AFTER_DRAIN = false;
    bf16_t* O; int ldc;
    __device__ __forceinline__ void operator()(const f32x4 (&acc)[2][2][4][2], const Unit& u, int wr, int wc, int fr, int fq) const {
        const int row0 = u.pm * BM + wr * 64 + fr, col0 = u.pn * HALF + wc * 32 + 8 * fq;
#pragma unroll
        for (int ai = 0; ai < 2; ++ai)
#pragma unroll
            for (int m = 0; m < 4; ++m) { bf16_t* rowp = O + (size_t)(row0 + ai * HALF + m * 16) * ldc + col0;
                float r[8];
#pragma unroll
                for (int n = 0; n < 2; ++n)
#pragma unroll
                    for (int i = 0; i < 4; ++i) { const float g = acc[ai][0][m][n][i], up = acc[ai][1][m][n][i]; r[4 * n + i] = g * __builtin_amdgcn_rcpf(1.0f + __expf(-g)) * up; }
                u32x4 w; w.x = cvt_pk_bf16(r[0], r[1]); w.y = cvt_pk_bf16(r[2], r[3]); w.z = cvt_pk_bf16(r[4], r[5]); w.w = cvt_pk_bf16(r[6], r[7]);
                *(u32x4*)rowp = w; }
    }
};
template <class Epi, class Sched, bool ALIGN_EPI = false, bool SP2 = false>
__device__ __forceinline__ void gemm_phase(PG8_LAS unsigned char* lds, const Gemm g, const Sched& S, const Epi& E) {
    int tid_ = threadIdx.x; asm volatile("" : "+v"(tid_));
    const int tid = tid_, wid = __builtin_amdgcn_readfirstlane(tid >> 6), lane = tid & 63, wr = wid >> 2, wc = wid & 3, fr = lane & 15, fq = lane >> 4;
    const int K = g.K, nt = K / BK;
    unsigned voffA[2], voffB[2];
#pragma unroll
    for (int i = 0; i < 2; ++i) { int R, C; stage_rc(tid * 16 + i * 8192, R, C); const int Rb = Epi::PERM ? ((R & ~31) + perm32(R & 31)) : R;
        voffA[i] = (unsigned)(R * K + C) * 2u; voffB[i] = (unsigned)(Rb * K + C) * 2u; }
    const size_t kstep = (size_t)(BK * 2);
    const size_t hstep = (size_t)HALF * K * 2;
    const size_t tstep = 2 * hstep;
    const unsigned ldsw = (unsigned)wid * 1024u;
    const int aoff = lds_byte(wr * 64 + fr, fq * 8), boff = lds_byte(wc * 32 + fr, fq * 8);
#define PG8_SA(b, h) (((b) * 2 + (h)) * HTB)
#define PG8_SB(b, h) ((4 + (b) * 2 + (h)) * HTB)
#define PG8_STAGE(bufoff, gbase, voff) do { _Pragma("unroll") for (int _i = 0; _i < 2; ++_i) \
        __builtin_amdgcn_global_load_lds((const unsigned*)((const char*)(gbase) + (voff)[_i]), (PG8_LAS unsigned*)(lds + (bufoff) + ldsw + _i * 8192), 16, 0, 0); } while (0)
#define PG8_LDA(dst, b, h) do { _Pragma("unroll") for (int m = 0; m < 4; ++m) _Pragma("unroll") for (int k = 0; k < 2; ++k) dst[m][k] = *(const PG8_LAS bf16x8*)(lds + PG8_SA(b, h) + aoff + m * 2048 + k * 1024); } while (0)
#define PG8_LDB(dst, b, h) do { _Pragma("unroll") for (int n = 0; n < 2; ++n) _Pragma("unroll") for (int k = 0; k < 2; ++k) dst[n][k] = *(const PG8_LAS bf16x8*)(lds + PG8_SB(b, h) + boff + n * 2048 + k * 1024); } while (0)
#define PG8_MMA(ai, bj, At, Bt) do { __builtin_amdgcn_s_setprio(1); _Pragma("unroll") for (int m = 0; m < 4; ++m) _Pragma("unroll") for (int n = 0; n < 2; ++n) _Pragma("unroll") for (int k = 0; k < 2; ++k) \
        acc[ai][bj][m][n] = __builtin_amdgcn_mfma_f32_16x16x32_bf16(Bt[n][k], At[m][k], acc[ai][bj][m][n], 0, 0, 0); __builtin_amdgcn_s_setprio(0); } while (0)
#define PG8_WAIT_V(n) asm volatile("s_waitcnt vmcnt(" #n ")" ::: "memory")
#define PG8_WAIT_L(n) asm volatile("s_waitcnt lgkmcnt(" #n ")" ::: "memory")
#define PG8_BAR __builtin_amdgcn_s_barrier()
#define PG8_SCHED __builtin_amdgcn_sched_barrier(0)
    Unit cur, nxt; int ui = 0;
    if (!S.next(0, cur)) return;
    f32x4 acc[2][2][4][2];
#pragma unroll
    for (int a = 0; a < 2; ++a)
#pragma unroll
        for (int b = 0; b < 2; ++b)
#pragma unroll
            for (int m = 0; m < 4; ++m)
#pragma unroll
                for (int n = 0; n < 2; ++n) acc[a][b][m][n] = (f32x4){0.f, 0.f, 0.f, 0.f};
    bf16x8 At[4][2], B0[2][2], B1[2][2];
    const char* cA = (const char*)g.A + (size_t)cur.pm * tstep; const char* cB = (const char*)g.Bt + (size_t)cur.pn * tstep;
    S.a_ready(cur);
    if constexpr (SP2) {
        PG8_STAGE(PG8_SB(0, 0), cB, voffB); PG8_STAGE(PG8_SB(0, 1), cB + hstep, voffB); PG8_STAGE(PG8_SA(0, 0), cA, voffA); PG8_STAGE(PG8_SA(0, 1), cA + hstep, voffA);
        if (wr == 1) PG8_BAR;
        PG8_WAIT_V(2); PG8_BAR;
        PG8_STAGE(PG8_SB(1, 0), cB + kstep, voffB); PG8_STAGE(PG8_SA(1, 0), cA + kstep, voffA); PG8_STAGE(PG8_SB(1, 1), cB + hstep + kstep, voffB);
        PG8_WAIT_V(6); PG8_BAR;
    } else {
        PG8_STAGE(PG8_SB(0, 0), cB, voffB); PG8_STAGE(PG8_SA(0, 0), cA, voffA); PG8_STAGE(PG8_SB(0, 1), cB + hstep, voffB); PG8_STAGE(PG8_SA(0, 1), cA + hstep, voffA);
        if (wr == 1) PG8_BAR;
        PG8_WAIT_V(4); PG8_BAR;
        PG8_STAGE(PG8_SB(1, 0), cB + kstep, voffB); PG8_STAGE(PG8_SA(1, 0), cA + kstep, voffA); PG8_STAGE(PG8_SB(1, 1), cB + hstep + kstep, voffB);
        PG8_WAIT_V(6); PG8_BAR;
    }
    for (;;) {
        const bool has_next = S.next(ui + 1, nxt);
        const char* nA = has_next ? (const char*)g.A + (size_t)nxt.pm * tstep : cA; const char* nB = has_next ? (const char*)g.Bt + (size_t)nxt.pn * tstep : cB;
        for (int t = 0; t < nt; t += 2) {
            const bool last = (t == nt - 2);
            const char* a1 = cA + (size_t)(t + 1) * kstep;
            const char* a2 = last ? nA : cA + (size_t)(t + 2) * kstep; const char* b2 = last ? nB : cB + (size_t)(t + 2) * kstep;
            const char* a3 = a2 + kstep; const char* b3 = b2 + kstep;
            if (last && has_next) S.a_ready(nxt);
            if constexpr (SP2) {
            PG8_LDB(B0, 0, 0); PG8_LDB(B1, 0, 1); PG8_SCHED; PG8_LDA(At, 0, 0); PG8_STAGE(PG8_SA(1, 1), a1 + hstep, voffA);
            PG8_WAIT_V(8); PG8_WAIT_L(0); PG8_BAR; PG8_MMA(0, 0, At, B0); PG8_MMA(0, 1, At, B1); PG8_BAR; PG8_SCHED;
            PG8_LDA(At, 0, 1); PG8_STAGE(PG8_SB(0, 0), b2, voffB); PG8_STAGE(PG8_SB(0, 1), b2 + hstep, voffB); PG8_STAGE(PG8_SA(0, 0), a2, voffA);
            PG8_WAIT_V(8); PG8_WAIT_L(0); PG8_BAR; PG8_MMA(1, 0, At, B0); PG8_MMA(1, 1, At, B1); PG8_BAR; PG8_SCHED;
            PG8_LDB(B0, 1, 0); PG8_LDB(B1, 1, 1); PG8_SCHED; PG8_LDA(At, 1, 0); PG8_STAGE(PG8_SA(0, 1), a2 + hstep, voffA);
            PG8_WAIT_V(8); PG8_WAIT_L(0); PG8_BAR; PG8_MMA(0, 0, At, B0); PG8_MMA(0, 1, At, B1); PG8_BAR; PG8_SCHED;
            PG8_LDA(At, 1, 1); PG8_STAGE(PG8_SB(1, 0), b3, voffB); PG8_STAGE(PG8_SB(1, 1), b3 + hstep, voffB); PG8_STAGE(PG8_SA(1, 0), a3, voffA);
            PG8_WAIT_V(8); PG8_WAIT_L(0); PG8_BAR; PG8_MMA(1, 0, At, B0); PG8_MMA(1, 1, At, B1); PG8_BAR; PG8_SCHED;
            } else {
            PG8_LDB(B0, 0, 0); PG8_SCHED; PG8_LDA(At, 0, 0); PG8_STAGE(PG8_SA(1, 1), a1 + hstep, voffA);
            PG8_WAIT_L(8); PG8_BAR; PG8_WAIT_L(0); PG8_MMA(0, 0, At, B0); PG8_BAR; PG8_SCHED;
            PG8_LDB(B1, 0, 1); PG8_STAGE(PG8_SB(0, 0), b2, voffB);
            PG8_BAR; PG8_WAIT_L(0); PG8_MMA(0, 1, At, B1); PG8_BAR;
            PG8_LDA(At, 0, 1); PG8_STAGE(PG8_SA(0, 0), a2, voffA);
            PG8_BAR; PG8_WAIT_L(0); PG8_MMA(1, 0, At, B0); PG8_BAR; PG8_SCHED;
            PG8_STAGE(PG8_SB(0, 1), b2 + hstep, voffB);
            PG8_WAIT_V(6); PG8_BAR; PG8_MMA(1, 1, At, B1); PG8_BAR;
            PG8_LDB(B0, 1, 0); PG8_SCHED; PG8_LDA(At, 1, 0); PG8_STAGE(PG8_SA(0, 1), a2 + hstep, voffA);
            PG8_WAIT_L(8); PG8_BAR; PG8_WAIT_L(0); PG8_MMA(0, 0, At, B0); PG8_BAR; PG8_SCHED;
            PG8_LDB(B1, 1, 1); PG8_STAGE(PG8_SB(1, 0), b3, voffB);
            PG8_BAR; PG8_WAIT_L(0); PG8_MMA(0, 1, At, B1); PG8_BAR;
            PG8_LDA(At, 1, 1); PG8_STAGE(PG8_SA(1, 0), a3, voffA);
            PG8_BAR; PG8_WAIT_L(0); PG8_MMA(1, 0, At, B0); PG8_BAR; PG8_SCHED;
            PG8_STAGE(PG8_SB(1, 1), b3 + hstep, voffB);
            PG8_WAIT_V(6); PG8_BAR; PG8_MMA(1, 1, At, B1); PG8_BAR;
            }
        }
        if constexpr (ALIGN_EPI) { if (wr == 0) PG8_BAR; }
        if constexpr (!Epi::AFTER_DRAIN) { E(acc, cur, wr, wc, fr, fq); S.done(cur); }
        if (!has_next) break;
#pragma unroll
        for (int a = 0; a < 2; ++a)
#pragma unroll
            for (int b = 0; b < 2; ++b)
#pragma unroll
                for (int m = 0; m < 4; ++m)
#pragma unroll
                    for (int n = 0; n < 2; ++n) acc[a][b][m][n] = (f32x4){0.f, 0.f, 0.f, 0.f};
        cur = nxt; cA = nA; cB = nB; ++ui;
        if constexpr (ALIGN_EPI) { if (wr == 1) PG8_BAR; }
    }
    PG8_WAIT_V(0);
    if constexpr (!ALIGN_EPI) { if (wr == 0) PG8_BAR; }
    PG8_BAR;
    if constexpr (Epi::AFTER_DRAIN) { E.fused(acc, cur, wr, wc, fr, fq, lds, wid, lane); S.done(cur); }
#undef PG8_SA
#undef PG8_SB
#undef PG8_STAGE
#undef PG8_LDA
#undef PG8_LDB
#undef PG8_MMA
#undef PG8_WAIT_V
#undef PG8_WAIT_L
#undef PG8_BAR
#undef PG8_SCHED
}
}

#ifndef PG8_SP2
#define PG8_SP2 true
#endif
#ifndef PG8_ALIGN
#define PG8_ALIGN true
#endif
#include <hip/hip_bf16.h>
namespace attn128 {
using bf16=__hip_bfloat16;
using bf16x8=__attribute__((ext_vector_type(8)))short;
using s16x4=__attribute__((ext_vector_type(4)))short;
using f32x16=__attribute__((ext_vector_type(16)))float;
using u32x4=__attribute__((ext_vector_type(4)))unsigned;
constexpr int SEQ=16384,PIN=6144,POUT=2048,QB=256,NQB=SEQ/QB;
constexpr int KBUF=8192,VBUF=16384;
constexpr int LDS_K=0,LDS_V=3*KBUF,LDS_OST=0,LDS_WS=65536,LDS_Q=LDS_WS+8*64*4,LDS_BYTES=LDS_Q+8*4096;
constexpr float C2=0.125f*1.4426950408889634f;
__device__ __forceinline__ int crow(int r,int hi){return (r&3)+8*(r>>2)+4*hi;}
__device__ __forceinline__ void glds16(const void*gsrc,unsigned lds_dst){unsigned keep;
  asm volatile("s_mov_b32 %0, m0\n\ts_mov_b32 m0, %2\n\ts_nop 0\n\tglobal_load_lds_dwordx4 %1, off\n\ts_mov_b32 m0, %0":"=&s"(keep):"v"(gsrc),"s"(lds_dst):"memory");}
__device__ __forceinline__ void glds16s(const void*sbase,unsigned voff,unsigned lds_dst){unsigned keep;
  asm volatile("s_mov_b32 %0, m0\n\ts_mov_b32 m0, %3\n\ts_nop 0\n\tglobal_load_lds_dwordx4 %1, %2\n\ts_mov_b32 m0, %0":"=&s"(keep):"v"(voff),"s"(sbase),"s"(lds_dst):"memory");}
typedef float f32x2_t __attribute__((ext_vector_type(2))); typedef __bf16 bf16x2_t __attribute__((ext_vector_type(2)));
__device__ __forceinline__ unsigned cvtpk_s(float lo,float hi){f32x2_t v={lo,hi};bf16x2_t b=__builtin_convertvector(v,bf16x2_t);return __builtin_bit_cast(unsigned,b);}
__device__ __forceinline__ float max3f(float a,float b,float c){float r;asm("v_max3_f32 %0, %1, %2, %3":"=v"(r):"v"(a),"v"(b),"v"(c));return r;}
__device__ __forceinline__ float max2f(float a,float b){float r;asm("v_max_f32_e32 %0, %1, %2":"=v"(r):"v"(a),"v"(b));return r;}
typedef __attribute__((address_space(3))) const char* lds_cptr;
typedef short v4i16_t __attribute__((ext_vector_type(4)));
__device__ __forceinline__ s16x4 vtr(lds_cptr p){ return __builtin_bit_cast(s16x4,__builtin_amdgcn_ds_read_tr16_b64_v4i16((__attribute__((address_space(3))) v4i16_t*)p)); }
#define A128_WAITBAR() asm volatile("s_waitcnt vmcnt(0) lgkmcnt(0)\n\ts_barrier":::"memory")
#define SB() __builtin_amdgcn_sched_barrier(0)
#define LDSQ(p) (*(const __attribute__((address_space(3))) bf16x8*)(p))
#define MF32(a,b,c) __builtin_amdgcn_mfma_f32_32x32x16_bf16(a,b,c,0,0,0)
#define EXP1(x) x=__builtin_amdgcn_exp2f((x)-mh_)
struct St { float mhat,l_reg; f32x16 o[4]; };
template<bool GUARD> __device__ __forceinline__ float rowmax32(f32x16&p0,f32x16&p1){
  if(GUARD) asm volatile("s_nop 15\n\ts_nop 7":"+v"(p0),"+v"(p1));
  float a=max3f(p0[0],p0[1],p1[0]),b=max3f(p0[2],p0[3],p1[1]);a=max3f(a,p1[2],p1[3]);
  #pragma unroll
  for(int r=4;r<16;r+=4){a=max3f(a,p0[r],p0[r+1]);b=max3f(b,p0[r+2],p0[r+3]);a=max3f(a,p1[r],p1[r+1]);b=max3f(b,p1[r+2],p1[r+3]);}
  const float m=max2f(a,b); auto rr=__builtin_amdgcn_permlane32_swap(__float_as_uint(m),__float_as_uint(m),false,false);
  return max2f(__uint_as_float(rr[0]),__uint_as_float(rr[1]));
}
template<int THRL,bool FIRST> __device__ __forceinline__ void decide(float rm,St&S,float*wsf,int r32,int hi){
  if(FIRST){ S.mhat=rm; }
  else if(__any(rm-S.mhat>(float)THRL)){
    const float dl=__builtin_fmaxf(rm-S.mhat,0.f); S.mhat+=dl;
    const float f=__builtin_amdgcn_exp2f(-dl); S.l_reg*=f; if(hi==0)wsf[r32]=f;
    asm volatile("s_waitcnt lgkmcnt(0)":::"memory");
    #pragma unroll
    for(int r=0;r<16;++r){ const float fr=wsf[crow(r,hi)];
      #pragma unroll
      for(int d=0;d<4;++d)S.o[d][r]*=fr; }
  }
}
template<int THRL,bool FIRST> __device__ __forceinline__ void softmax_head(f32x16&p0,f32x16&p1,St&S,float*wsf,int r32,int hi){ decide<THRL,FIRST>(rowmax32<true>(p0,p1),S,wsf,r32,hi); }
__device__ __forceinline__ bf16x8 vfrag(lds_cptr vp,int i){ const s16x4 lo=vtr(vp+(i&3)*4096+(i>>2)*1024), hh=vtr(vp+(i&3)*4096+(i>>2)*1024+512); return (bf16x8){lo[0],lo[1],lo[2],lo[3],hh[0],hh[1],hh[2],hh[3]}; }
__device__ __forceinline__ u32x4 packw(const f32x16&p,int base){ u32x4 w; w[0]=cvtpk_s(p[base],p[base+1]); w[1]=cvtpk_s(p[base+2],p[base+3]); w[2]=cvtpk_s(p[base+4],p[base+5]); w[3]=cvtpk_s(p[base+6],p[base+7]); return w; }
__device__ __forceinline__ void qk_plain(f32x16&n0,f32x16&n1,lds_cptr kp,lds_cptr qp){
  bf16x8 qa=LDSQ(qp),qb=LDSQ(qp+1024); const f32x16 z=f32x16{};
  n0=MF32(LDSQ(kp),qa,z); n1=MF32(LDSQ(kp+512),qa,z); qa=LDSQ(qp+2048);
  n0=MF32(LDSQ(kp+2048),qb,n0); n1=MF32(LDSQ(kp+2560),qb,n1); qb=LDSQ(qp+3072);
  n0=MF32(LDSQ(kp+4096),qa,n0); n1=MF32(LDSQ(kp+4608),qa,n1);
  n0=MF32(LDSQ(kp+6144),qb,n0); n1=MF32(LDSQ(kp+6656),qb,n1);
}
__device__ __forceinline__ void expsum_pv_plain(f32x16&p0,f32x16&p1,St&S,lds_cptr vp){
  float s=0.f; const float mh_=S.mhat;
  #pragma unroll
  for(int r=0;r<16;++r){EXP1(p0[r]);EXP1(p1[r]);s+=p0[r]+p1[r];}
  S.l_reg+=s;
  u32x4 pw[4]; pw[0]=packw(p0,0); pw[1]=packw(p0,8); pw[2]=packw(p1,0); pw[3]=packw(p1,8);
  #pragma unroll
  for(int i=0;i<16;++i){ const bf16x8 vf=vfrag(vp,i); S.o[i&3]=MF32(__builtin_bit_cast(bf16x8,pw[i>>2]),vf,S.o[i&3]); }
}
template<int THRL,bool FIRST> __device__ __forceinline__ void step_main(f32x16&p0,f32x16&p1,f32x16&n0,f32x16&n1,St&S,lds_cptr kpn,lds_cptr qp,lds_cptr vp,float*wsf,int r32,int hi,float&rm){
  #define KF(i) LDSQ(kpn+((i)>>1)*2048+((i)&1)*512)
  #define QF(d0) LDSQ(qp+(d0)*1024)
  bf16x8 ka=KF(0),kb=KF(1),kc=KF(2),kd=KF(3),qa=QF(0),qb=QF(1);
  decide<THRL,FIRST>(rm,S,wsf,r32,hi);
  u32x4 pw0,pw1,pw2,pw3; const float mh_=S.mhat; const f32x16 z=f32x16{};
  SB();
  n0=MF32(ka,qa,z); ka=KF(4); EXP1(p0[0]);EXP1(p0[1]);EXP1(p0[2]); SB();
  n1=MF32(kb,qa,z); kb=KF(5); qa=QF(2); EXP1(p0[3]);EXP1(p0[4]);EXP1(p0[5]); SB();
  n0=MF32(kc,qb,n0);   kc=KF(6); EXP1(p0[6]);EXP1(p0[7]);EXP1(p0[8]); SB();
  n1=MF32(kd,qb,n1);   kd=KF(7); qb=QF(3); EXP1(p0[9]);EXP1(p0[10]);EXP1(p0[11]); SB();
  bf16x8 vfa=vfrag(vp,0);
  n0=MF32(ka,qa,n0);   EXP1(p0[12]);EXP1(p0[13]);EXP1(p0[14]); pw0=packw(p0,0); SB();
  bf16x8 vfb=vfrag(vp,1);
  n1=MF32(kb,qa,n1);   EXP1(p0[15]);EXP1(p1[0]);EXP1(p1[1]); SB();
  bf16x8 vfc=vfrag(vp,2);
  n0=MF32(kc,qb,n0);   EXP1(p1[2]);EXP1(p1[3]);EXP1(p1[4]); pw1=packw(p0,8); SB();
  bf16x8 vfd=vfrag(vp,3);
  n1=MF32(kd,qb,n1);   EXP1(p1[5]);EXP1(p1[6]);EXP1(p1[7]); SB();
  #undef KF
  #undef QF
  float sa=p0[0]+p0[1];
  #define PVG(i,PW,VF,NEXTI,X0,X1,Y0,Y1,EXTRA) do{ S.o[(i)&3]=MF32(__builtin_bit_cast(bf16x8,PW),VF,S.o[(i)&3]); if((NEXTI)<16){ VF=vfrag(vp,(NEXTI)<16?(NEXTI):0); } sa+=X0; sa+=X1; sa+=Y0; sa+=Y1; EXTRA; SB(); }while(0)
  PVG(0,pw0,vfa,4, p0[2],p0[3],p0[4],p0[5],   do{EXP1(p1[8]);EXP1(p1[9]);}while(0));
  PVG(1,pw0,vfb,5, p0[6],p0[7],p0[8],p0[9], do{EXP1(p1[10]);EXP1(p1[11]);}while(0));
  PVG(2,pw0,vfc,6, p0[10],p0[11],p0[12],p0[13], do{EXP1(p1[12]);EXP1(p1[13]);}while(0));
  PVG(3,pw0,vfd,7, p0[14],p0[15],p1[0],p1[1],   do{EXP1(p1[14]);EXP1(p1[15]);}while(0));
  PVG(4,pw1,vfa,8, p1[2],p1[3],p1[4],p1[5],   pw2=packw(p1,0));
  PVG(5,pw1,vfb,9, p1[6],p1[7],p1[8],p1[9], pw3=packw(p1,8));
  PVG(6,pw1,vfc,10, p1[10],p1[11],p1[12],p1[13], do{}while(0));
  PVG(7,pw1,vfd,11, p1[14],p1[15],0.f,0.f, do{}while(0));
  float ma,mb;
  #define PINAB() asm volatile("":"+v"(ma),"+v"(mb))
  PVG(8,pw2,vfa,12,0.f,0.f,0.f,0.f, do{ma=max3f(n0[0],n0[1],n1[0]);mb=max3f(n0[2],n0[3],n1[1]);PINAB();}while(0));
  PVG(9,pw2,vfb,13,0.f,0.f,0.f,0.f, do{ma=max3f(ma,n1[2],n1[3]);mb=max3f(mb,n0[4],n0[5]);PINAB();}while(0));
  PVG(10,pw2,vfc,14,0.f,0.f,0.f,0.f, do{ma=max3f(ma,n0[6],n0[7]);mb=max3f(mb,n1[4],n1[5]);PINAB();}while(0));
  PVG(11,pw2,vfd,15,0.f,0.f,0.f,0.f, do{ma=max3f(ma,n1[6],n1[7]);mb=max3f(mb,n0[8],n0[9]);PINAB();}while(0));
  PVG(12,pw3,vfa,16,0.f,0.f,0.f,0.f, do{ma=max3f(ma,n0[10],n0[11]);mb=max3f(mb,n1[8],n1[9]);PINAB();}while(0));
  PVG(13,pw3,vfb,16,0.f,0.f,0.f,0.f, do{ma=max3f(ma,n1[10],n1[11]);mb=max3f(mb,n0[12],n0[13]);PINAB();}while(0));
  PVG(14,pw3,vfc,16,0.f,0.f,0.f,0.f, do{ma=max3f(ma,n0[14],n0[15]);mb=max3f(mb,n1[12],n1[13]);PINAB();}while(0));
  PVG(15,pw3,vfd,16,0.f,0.f,0.f,0.f, do{ma=max3f(ma,n1[14],n1[15]);ma=max2f(ma,mb);PINAB();}while(0));
  #undef PINAB
  { auto rr=__builtin_amdgcn_permlane32_swap(__float_as_uint(ma),__float_as_uint(ma),false,false); rm=max2f(__uint_as_float(rr[0]),__uint_as_float(rr[1])); }
  #undef PVG
  S.l_reg+=sa;
}
template<int THRL> __device__ __forceinline__ void unit(int qb,const bf16*Q,const bf16*K,const bf16*V,bf16*O,char*shm){
  int tid_=threadIdx.x; asm volatile("":"+v"(tid_));
  const int tid=tid_,lane=tid&63,r32=lane&31,hi=lane>>5; const int wid=__builtin_amdgcn_readfirstlane(tid>>6);
  const int q0=qb*QB;
  const bf16*Qw=Q+(long)(q0+wid*32)*PIN;
  const unsigned lds0=(unsigned)(uintptr_t)shm;
  float*wsf=(float*)(shm+LDS_WS)+wid*64;
  const unsigned koff=(unsigned)(lane*PIN+wid*8)*2u;
  const unsigned voff=(unsigned)((16*(wid&3)+(lane>>2))*PIN+(wid>>2)*32+(lane&3)*8)*2u;
  const unsigned kdst=lds0+LDS_K+wid*1024, vdst=lds0+LDS_V+wid*1024;
  #define DMA_K(t,so) glds16s((const char*)K+(size_t)(t)*(64*PIN*2),koff,(unsigned)__builtin_amdgcn_readfirstlane(kdst+(so)))
  #define DMA_V(t,so) do{ glds16s((const char*)V+(size_t)(t)*(64*PIN*2),voff,(unsigned)__builtin_amdgcn_readfirstlane(vdst+(so))); glds16s((const char*)V+(size_t)(t)*(64*PIN*2)+128,voff,(unsigned)__builtin_amdgcn_readfirstlane(vdst+(so)+8192)); }while(0)
  const lds_cptr shm3=(lds_cptr)shm; const lds_cptr kp0=shm3+LDS_K+hi*1024+r32*16; const lds_cptr vp0=shm3+LDS_V+((lane>>4)&1)*32+(lane&3)*8+(4*hi+((lane&15)>>2))*64;
  const lds_cptr qp=shm3+LDS_Q+wid*4096+hi*512+r32*16;
  const int NT=(q0+QB)/64, g=wid>>1;
  DMA_K(0,0); DMA_V(0,0); DMA_K(1,KBUF);
  { bf16x8 qt[4];
    #pragma unroll
    for(int d0=0;d0<4;++d0)qt[d0]=*reinterpret_cast<const bf16x8*>(&Qw[(long)r32*PIN+d0*16+hi*8]);
    #pragma unroll
    for(int d0=0;d0<4;++d0)*(__attribute__((address_space(3))) bf16x8*)(shm3+LDS_Q+wid*4096+hi*512+r32*16+d0*1024)=qt[d0]; }
  St S; S.mhat=0.f; S.l_reg=0.f;
  #pragma unroll
  for(int d=0;d<4;++d)S.o[d]=f32x16{};
  A128_WAITBAR();
  f32x16 pA0,pA1,pB0,pB1;
  qk_plain(pA0,pA1,kp0,qp);
  float rm=0.f;
  int ks1=KBUF, ks2=2*KBUF;
  #define ROT() do{ ks1=ks2; ks2=(ks2==2*KBUF)?0:ks2+KBUF; }while(0)
  int t=0;
  if(NT>4){
    rm=rowmax32<true>(pA0,pA1);
    DMA_K(2,ks2); DMA_V(1,VBUF);
    step_main<THRL,true>(pA0,pA1,pB0,pB1,S,kp0+ks1,qp,vp0,wsf,r32,hi,rm); A128_WAITBAR(); ROT();
    DMA_K(3,ks2); DMA_V(2,0);
    step_main<THRL,false>(pB0,pB1,pA0,pA1,S,kp0+ks1,qp,vp0+VBUF,wsf,r32,hi,rm); A128_WAITBAR(); ROT();
    for(t=2;t<NT-4;t+=2){
      DMA_K(t+2,ks2); DMA_V(t+1,VBUF);
      step_main<THRL,false>(pA0,pA1,pB0,pB1,S,kp0+ks1,qp,vp0,wsf,r32,hi,rm); A128_WAITBAR(); ROT();
      DMA_K(t+3,ks2); DMA_V(t+2,0);
      step_main<THRL,false>(pB0,pB1,pA0,pA1,S,kp0+ks1,qp,vp0+VBUF,wsf,r32,hi,rm); A128_WAITBAR(); ROT();
    }
  }
  #define BAND(jb,P0,P1,N0,N1,VOFF) do{ const int tt=NT-4+(jb); \
      if((jb)+2<4) DMA_K(tt+2,ks2); if((jb)+1<4) DMA_V(tt+1,(VOFF)^VBUF); \
      if((jb)<=g){ if(tt==0) softmax_head<THRL,true>(P0,P1,S,wsf,r32,hi); else softmax_head<THRL,false>(P0,P1,S,wsf,r32,hi); } \
      if((jb)+1<4&&(jb)+1<=g) qk_plain(N0,N1,kp0+ks1,qp); \
      if((jb)<=g) expsum_pv_plain(P0,P1,S,vp0+(VOFF)); \
      A128_WAITBAR(); ROT(); }while(0)
  BAND(0,pA0,pA1,pB0,pB1,0);
  BAND(1,pB0,pB1,pA0,pA1,VBUF);
  BAND(2,pA0,pA1,pB0,pB1,0);
  BAND(3,pB0,pB1,pA0,pA1,VBUF);
  #undef BAND
  #undef ROT
  float l_reg=S.l_reg;
  {auto rr=__builtin_amdgcn_permlane32_swap(__float_as_uint(l_reg),__float_as_uint(l_reg),false,false);l_reg=__uint_as_float(rr[0])+__uint_as_float(rr[1]);}
  if(hi==0)wsf[32+r32]=l_reg; asm volatile("s_waitcnt lgkmcnt(0)":::"memory");
  bf16*Ow=O+(long)(q0+wid*32)*POUT;
  { bf16*stg=(bf16*)(shm+LDS_OST)+wid*4096;
    #pragma unroll
    for(int r=0;r<16;++r){ const int orow=crow(r,hi); const float rl=__builtin_amdgcn_rcpf(wsf[32+orow]);
      #pragma unroll
      for(int d=0;d<4;++d)stg[orow*128+d*32+r32]=__float2bfloat16(S.o[d][r]*rl); }
    asm volatile("s_waitcnt lgkmcnt(0)":::"memory");
    #pragma unroll
    for(int i=0;i<8;++i){ const int row=i*4+(lane>>4),ch=lane&15; const u32x4 v=*(const u32x4*)(stg+row*128+ch*8); *(u32x4*)(Ow+(long)row*POUT+ch*8)=v; } }
  asm volatile("s_waitcnt lgkmcnt(0)\n\ts_barrier":::"memory");
  #undef DMA_K
  #undef DMA_V
}
struct AttnTensors { const bf16* QKV; bf16* O; };
template<int THRL=8> __device__ __forceinline__ void attn_phase(char*lds,const AttnTensors&T,int grid,int block){
  for(int v0=block;v0<256;v0+=grid){
    const int vcu=(v0%8)*32+v0/8, hc=vcu>>4, s=vcu&15, h=hc>>1;
    const bf16*Q=T.QKV+3072+hc*64,*K=T.QKV+4096+hc*64,*V=T.QKV+5120+h*128; bf16*O=T.O+hc*128;
    for(int i=3;i>=0;--i){ const int qb=(i&1)?(32*(i>>1)+31-s):(32*(i>>1)+s); unit<THRL>(qb,Q,K,V,O,lds); }
  }
}
#undef A128_WAITBAR
}
constexpr int M = 16384, DM = 2048, NPROJ = 6144, FF = 5632, NGU = 2 * FF;
constexpr int MH = 4, DQK = 128, DV = 256, CH = 64, NCH = M / CH;
constexpr float EPS = 1e-6f;
constexpr float LAM_INIT = 0.2f;
constexpr int PC_MV = 1024, PC_MO = 2048, PC_AQ = 3072;
constexpr size_t MiB = 1u << 20;
constexpr size_t WS_GATES = 0;
constexpr size_t WS_LOGF = 512 * 1024;
constexpr size_t WS_IG = 768 * 1024;
constexpr size_t WS_GDEC = 1024 * 1024;
constexpr size_t WS_UN = 1536 * 1024;
constexpr size_t WS_NST = 2048 * 1024;
constexpr size_t WS_BAR = 3072 * 1024;
constexpr size_t WS_WIN = 4 * MiB;
constexpr size_t WS_QKM = 4 * MiB;
constexpr size_t WS_WOUT = 36 * MiB;
constexpr size_t WS_WGU = 44 * MiB;
constexpr size_t WS_WD = 88 * MiB;
constexpr size_t WS_XN = 110 * MiB;
constexpr size_t WS_ATTO = 110 * MiB;
constexpr size_t WS_PROJ = 174 * MiB;
constexpr size_t WS_ACT = 174 * MiB;
constexpr size_t WS_CT = 366 * MiB;
constexpr size_t WS_CAT = 430 * MiB;
constexpr size_t WS_TAB = 494 * MiB;
constexpr size_t WS_END = 498 * MiB;

constexpr int LDS_BYTES = 147456;
#define LAS __attribute__((address_space(3)))
typedef unsigned short bf16;
typedef float f32x4 __attribute__((ext_vector_type(4)));
typedef unsigned u32x4 __attribute__((ext_vector_type(4)));
typedef unsigned u32x2 __attribute__((ext_vector_type(2)));
typedef short bf16x8 __attribute__((ext_vector_type(8)));
#define LDS_WAIT() asm volatile("s_waitcnt lgkmcnt(0)" ::: "memory")

__device__ __forceinline__ float bf2f(unsigned h) { return __uint_as_float(h << 16); }
__device__ __forceinline__ unsigned pk2(float lo, float hi) { return pg8::cvt_pk_bf16(lo, hi); }
__device__ __forceinline__ float wave_sum(float v) {
#pragma unroll
    for (int o = 1; o < 64; o <<= 1) v += __shfl_xor(v, o);
    return v;
}
__device__ __forceinline__ float sigmoidf_(float v) { return 1.0f / (1.0f + __expf(-v)); }

struct Args {
    const float* in[19]; float* out; unsigned char* ws; float inv[32]; int ph_lo, ph_hi;
};
struct Ctx { LAS unsigned char* lds; int tid, lane, wave, G, bid; unsigned char* ws; };

__device__ __forceinline__ void p0_transpose_item(const float* W, int K, int Nsrc, int src_col0, bf16* WT, int dst_row0, int kb, LAS float* scr, int lane, bool perm = false) {
    const int k0 = 64 * kb, c4 = lane & 15, kr = lane >> 4;
    f32x4 v[16];
#pragma unroll
    for (int i = 0; i < 16; ++i) v[i] = *(const f32x4*)(W + (size_t)(k0 + 4 * i + kr) * Nsrc + src_col0 + 4 * c4);
#pragma unroll
    for (int i = 0; i < 16; ++i) { LAS float* d = scr + (4 * i + kr) * 65 + 4 * c4; d[0] = v[i].x; d[1] = v[i].y; d[2] = v[i].z; d[3] = v[i].w; }
    LDS_WAIT(); asm volatile("" ::: "memory");
    const int c = lane & 7;
#pragma unroll
    for (int j = 0; j < 8; ++j) { const int n = (lane >> 3) + 8 * j, sc = perm ? ((n >> 1) + 32 * (n & 1)) : n; const LAS float* p = scr + (8 * c) * 65 + sc;
        u32x4 o; o.x = pk2(p[0 * 65], p[1 * 65]); o.y = pk2(p[2 * 65], p[3 * 65]); o.z = pk2(p[4 * 65], p[5 * 65]); o.w = pk2(p[6 * 65], p[7 * 65]);
        *(u32x4*)(WT + (size_t)(dst_row0 + n) * K + k0 + 8 * c) = o; }
    LDS_WAIT(); asm volatile("" ::: "memory");
}
template <int PART  > __device__ __forceinline__ void p0_weights(const Ctx& C, const float* w_in, const float* w_out, const float* w_gate, const float* w_up, const float* w_down) {
    LAS float* scr = (LAS float*)(C.lds + C.wave * 16640);
    const int gw = C.bid * 8 + C.wave, NGW = C.G * 8;
    constexpr int I_IN = 32 * 96, I_OUT = 32 * 32, I_G = 32 * 88, I_D = 88 * 32;
    constexpr int NITEMS = I_IN + I_OUT + 2 * I_G + I_D;
    bf16* WinT = (bf16*)(C.ws + WS_WIN); bf16* WoutT = (bf16*)(C.ws + WS_WOUT); bf16* WguT = (bf16*)(C.ws + WS_WGU); bf16* WdT = (bf16*)(C.ws + WS_WD);
    constexpr int IT_LO = PART == 0 ? 0 : I_IN, IT_HI = PART == 0 ? I_IN : NITEMS;
    for (int it = IT_LO + gw; it < IT_HI; it += NGW) {
        int r = it;
        if (r < I_IN) { const int kb = r / 96, nb = r % 96, n0 = 64 * nb; const bool rp = (n0 >= 3072 && n0 < 5120);
            p0_transpose_item(w_in, DM, 6152, n0 + (n0 >= 3072 ? 8 : 0), WinT, n0, kb, scr, C.lane, rp); continue; } r -= I_IN;
        if (r < I_OUT) { const int kb = r / 32, nb = r % 32; p0_transpose_item(w_out, DM, DM, 64 * nb, WoutT, 64 * nb, kb, scr, C.lane); continue; } r -= I_OUT;
        if (r < I_G) { const int kb = r / 88, nb = r % 88, n0 = 64 * nb; p0_transpose_item(w_gate, DM, FF, n0, WguT, (n0 >> 7) * 256 + (n0 & 127), kb, scr, C.lane); continue; } r -= I_G;
        if (r < I_G) { const int kb = r / 88, nb = r % 88, n0 = 64 * nb; p0_transpose_item(w_up, DM, FF, n0, WguT, (n0 >> 7) * 256 + 128 + (n0 & 127), kb, scr, C.lane); continue; } r -= I_G;
        { const int kb = r / 32, nb = r % 32; p0_transpose_item(w_down, FF, DM, 64 * nb, WdT, 64 * nb, kb, scr, C.lane); }
    }
}
template <int MODE> __device__ __forceinline__ void rows_pass(const Ctx& C, const float* src, const float* g, bf16* dst_bf, float* dst_f, const LAS float* wg, const float* b_ig = nullptr, const float* b_fg = nullptr, const bf16* add_bf = nullptr, const bf16* add2_bf = nullptr) {
    const int gw = C.bid * 8 + C.wave, NGW = C.G * 8, lane = C.lane;
    for (int m = gw; m < M; m += NGW) {
        const f32x4* xr = (const f32x4*)(src + (size_t)m * DM) + lane;
        f32x4 v[8]; float ss = 0.f;
#pragma unroll
        for (int j = 0; j < 8; ++j) v[j] = xr[64 * j];
        if (MODE != 0) { const u32x2* ar = (const u32x2*)(add_bf + (size_t)m * DM) + lane;
#pragma unroll
            for (int j = 0; j < 8; ++j) { const u32x2 a = ar[64 * j]; v[j].x += bf2f(a.x & 0xffffu); v[j].y += bf2f(a.x >> 16); v[j].z += bf2f(a.y & 0xffffu); v[j].w += bf2f(a.y >> 16); }
            if (MODE == 2) { const u32x2* ar2 = (const u32x2*)(add2_bf + (size_t)m * DM) + lane;
#pragma unroll
                for (int j = 0; j < 8; ++j) { const u32x2 a = ar2[64 * j]; v[j].x += bf2f(a.x & 0xffffu); v[j].y += bf2f(a.x >> 16); v[j].z += bf2f(a.y & 0xffffu); v[j].w += bf2f(a.y >> 16); } } }
#pragma unroll
        for (int j = 0; j < 8; ++j) ss += (v[j].x * v[j].x + v[j].y * v[j].y) + (v[j].z * v[j].z + v[j].w * v[j].w);
        const float rs = 1.0f / sqrtf(wave_sum(ss) * (1.0f / DM) + EPS);
#pragma unroll
        for (int j = 0; j < 8; ++j) { const f32x4 gg = ((const f32x4*)g)[64 * j + lane]; v[j] = v[j] * rs * gg; }
        if (MODE == 2) {
            f32x4* o = (f32x4*)(dst_f + (size_t)m * DM) + lane;
#pragma unroll
            for (int j = 0; j < 8; ++j) o[64 * j] = v[j];
        } else {
            u32x2* o = (u32x2*)(dst_bf + (size_t)m * DM) + lane;
#pragma unroll
            for (int j = 0; j < 8; ++j) { u32x2 w; w.x = pk2(v[j].x, v[j].y); w.y = pk2(v[j].z, v[j].w); o[64 * j] = w; }
        }
        if (MODE == 0) {
            float ga[8];
#pragma unroll
            for (int q = 0; q < 8; ++q) { float a = 0.f;
#pragma unroll
                for (int j = 0; j < 8; ++j) { const f32x4 w = ((const LAS f32x4*)(wg + q * DM))[64 * j + lane]; a += (v[j].x * w.x + v[j].y * w.y) + (v[j].z * w.z + v[j].w * w.w); }
                ga[q] = wave_sum(a); }
            float mine = ga[0];
#pragma unroll
            for (int q = 1; q < 8; ++q) mine = (lane == q) ? ga[q] : mine;
            if (lane < 8) { const int hh = lane & 3; const float pre = mine + (lane < 4 ? b_ig[hh] : b_fg[hh]); const float cp = 15.0f * tanhf(pre * (1.0f / 15.0f));
                if (lane < 4) ((float*)(C.ws + WS_IG))[hh * M + m] = cp; else ((float*)(C.ws + WS_LOGF))[hh * M + m] = fminf(cp, 0.f) - log1pf(expf(-fabsf(cp))); }
        }
    }
}

namespace ml {
constexpr int VTS = 72, QKS = 136;
__device__ __forceinline__ float incl_scan64(float v, int lane) {
#pragma unroll
    for (int off = 1; off < 64; off <<= 1) { const float n = __shfl_up(v, off); if (lane >= off) v += n; }
    return v;
}
template <int NR> __device__ __forceinline__ void conv_rows(const bf16* PROJ, const float* conv_w, const float* conv_b, int chb, int trow0, float scale, float (&y)[NR][8]) {
    u32x4 xr[NR + 3];
#pragma unroll
    for (int k = 0; k < NR + 3; ++k) { const int t = trow0 - 3 + k; xr[k] = (t >= 0) ? *(const u32x4*)(PROJ + (size_t)t * NPROJ + chb) : (u32x4){0u, 0u, 0u, 0u}; }
    float cw[4][8], cb[8];
#pragma unroll
    for (int j = 0; j < 4; ++j) { const f32x4 a = *(const f32x4*)(conv_w + j * 1024 + chb), b = *(const f32x4*)(conv_w + j * 1024 + chb + 4);
        cw[j][0] = a.x; cw[j][1] = a.y; cw[j][2] = a.z; cw[j][3] = a.w; cw[j][4] = b.x; cw[j][5] = b.y; cw[j][6] = b.z; cw[j][7] = b.w; }
    { const f32x4 a = *(const f32x4*)(conv_b + chb), b = *(const f32x4*)(conv_b + chb + 4); cb[0] = a.x; cb[1] = a.y; cb[2] = a.z; cb[3] = a.w; cb[4] = b.x; cb[5] = b.y; cb[6] = b.z; cb[7] = b.w; }
#pragma unroll
    for (int r = 0; r < NR; ++r)
#pragma unroll
        for (int c = 0; c < 8; ++c) { float a = cb[c];
#pragma unroll
            for (int j = 0; j < 4; ++j) { const unsigned w = xr[r + j][c >> 1]; a += cw[j][c] * ((c & 1) ? bf2f(w >> 16) : bf2f(w & 0xffffu)); }
            y[r][c] = a * sigmoidf_(a) * scale; }
}
__device__ __forceinline__ void stage_vt(LAS bf16* VT, const bf16* PROJ, int row0, int col0, int wave, int lane) {
#pragma unroll
    for (int i = 0; i < 4; ++i) { const int ec = wave + 8 * i;
        const u32x4 v = *(const u32x4*)(PROJ + (size_t)(row0 + lane) * NPROJ + col0 + 8 * ec);
        LAS bf16* d = VT + (8 * ec) * VTS + lane;
        d[0 * VTS] = (bf16)(v.x & 0xffffu); d[1 * VTS] = (bf16)(v.x >> 16); d[2 * VTS] = (bf16)(v.y & 0xffffu); d[3 * VTS] = (bf16)(v.y >> 16);
        d[4 * VTS] = (bf16)(v.z & 0xffffu); d[5 * VTS] = (bf16)(v.z >> 16); d[6 * VTS] = (bf16)(v.w & 0xffffu); d[7 * VTS] = (bf16)(v.w >> 16); }
}
__device__ __forceinline__ void m1_phase(const Ctx& C, float* U, const float* conv_w, const float* conv_b) {
    const bf16* PROJ = (const bf16*)(C.ws + WS_PROJ);
    const float* LOGF = (const float*)(C.ws + WS_LOGF); const float* IG = (const float*)(C.ws + WS_IG);
    float* GDEC = (float*)(C.ws + WS_GDEC); float* UN = (float*)(C.ws + WS_UN);
    LAS bf16* VT = (LAS bf16*)C.lds; LAS bf16* KwT = (LAS bf16*)(C.lds + 36864); LAS float* wv = (LAS float*)(C.lds + 55296);
    const int lane = C.lane, wave = C.wave, fr = lane & 15, fq = lane >> 4;
    for (int unit = C.bid; unit < MH * NCH; unit += C.G) {
        const int h = unit >> 8, c = unit & 255, row0 = c * CH;
        if (wave == 0) { const float lf = LOGF[h * M + row0 + lane], ig = IG[h * M + row0 + lane]; const float b = incl_scan64(lf, lane); const float bl = __shfl(b, 63);
            wv[lane] = __expf(bl - b + ig); if (lane == 63) GDEC[unit] = __expf(bl); }
        const int cg = C.tid & 15, rgrp = C.tid >> 4; float y[2][8];
        conv_rows<2>(PROJ, conv_w, conv_b, 512 + h * DQK + 8 * cg, row0 + 2 * rgrp, 1.0f, y);
        stage_vt(VT, PROJ, row0, PC_MV + h * DV, wave, lane);
        __syncthreads();
        {
#pragma unroll
          for (int r = 0; r < 2; ++r) { const int sidx = 2 * rgrp + r; const float w = wv[sidx];
#pragma unroll
            for (int c = 0; c < 8; ++c) KwT[(8 * cg + c) * VTS + sidx] = (bf16)(pk2(y[r][c] * w, 0.f) & 0xffffu); } }
        __syncthreads();
        if (C.tid < DQK) { float s = 0.f;
#pragma unroll
            for (int j = 0; j < 64; ++j) s += bf2f(KwT[C.tid * VTS + j]);
            UN[unit * DQK + C.tid] = s; }
        f32x4 acc[2][8];
#pragma unroll
        for (int i = 0; i < 2; ++i)
#pragma unroll
            for (int dt = 0; dt < 8; ++dt) acc[i][dt] = (f32x4){0.f, 0.f, 0.f, 0.f};
        bf16x8 a[2][2];
#pragma unroll
        for (int i = 0; i < 2; ++i)
#pragma unroll
            for (int ks = 0; ks < 2; ++ks) a[i][ks] = *(const LAS bf16x8*)(VT + ((2 * wave + i) * 16 + fr) * VTS + 32 * ks + 8 * fq);
#pragma unroll
        for (int dt = 0; dt < 8; ++dt)
#pragma unroll
            for (int ks = 0; ks < 2; ++ks) { const bf16x8 b = *(const LAS bf16x8*)(KwT + (dt * 16 + fr) * VTS + 32 * ks + 8 * fq);
#pragma unroll
                for (int i = 0; i < 2; ++i) acc[i][dt] = __builtin_amdgcn_mfma_f32_16x16x32_bf16(a[i][ks], b, acc[i][dt], 0, 0, 0); }
        float* Uu = U + (size_t)unit * (DV * DQK);
#pragma unroll
        for (int i = 0; i < 2; ++i)
#pragma unroll
            for (int dt = 0; dt < 8; ++dt)
#pragma unroll
                for (int j = 0; j < 4; ++j) Uu[((2 * wave + i) * 16 + 4 * fq + j) * DQK + dt * 16 + fr] = acc[i][dt][j];
        __syncthreads();
    }
}
__device__ __forceinline__ void m2_scan(const Ctx& C, const float* U) {
    const float* GDEC = (const float*)(C.ws + WS_GDEC); const float* UN = (const float*)(C.ws + WS_UN); float* NST = (float*)(C.ws + WS_NST);
    bf16* CT = (bf16*)(C.ws + WS_CT);
    const int gtid = C.bid * 512 + C.tid, GT = C.G * 512;
    for (int e = gtid; e < MH * DV * DQK; e += GT) {
        const int h = e >> 15, idx = e & 32767; float st = 0.f;
        for (int c0 = 0; c0 < NCH; c0 += 32) {
            float u[32], g[32];
#pragma unroll
            for (int k = 0; k < 32; ++k) { const int unit = h * NCH + c0 + k; u[k] = U[(size_t)unit * (DV * DQK) + idx]; g[k] = GDEC[unit]; }
#pragma unroll
            for (int k = 0; k < 32; ++k) { const int unit = h * NCH + c0 + k; CT[(size_t)unit * (DV * DQK) + idx] = (bf16)(pk2(st, 0.f) & 0xffffu); st = g[k] * st + u[k]; }
        }
    }
    { const int e = (C.G - 1 - C.bid) * 2 + (C.tid >> 8), lsel = C.tid & 255;
      if (lsel == 0 && e < MH * DQK) { const int h = e >> 7, d = e & 127; float st = 0.f;
        for (int c0 = 0; c0 < NCH; c0 += 32) { float u[32], g[32];
#pragma unroll
            for (int k = 0; k < 32; ++k) { const int unit = h * NCH + c0 + k; u[k] = UN[unit * DQK + d]; g[k] = GDEC[unit]; }
#pragma unroll
            for (int k = 0; k < 32; ++k) { const int unit = h * NCH + c0 + k; NST[unit * DQK + d] = st; st = g[k] * st + u[k]; } } } }
}
__device__ __forceinline__ void m3_phase(const Ctx& C, const float* mnorm_g, const float* conv_w, const float* conv_b) {
    const bf16* PROJ = (const bf16*)(C.ws + WS_PROJ);
    const float* LOGF = (const float*)(C.ws + WS_LOGF); const float* IG = (const float*)(C.ws + WS_IG); const float* NST = (const float*)(C.ws + WS_NST);
    const bf16* CT = (const bf16*)(C.ws + WS_CT); bf16* CAT = (bf16*)(C.ws + WS_CAT);
    LAS bf16* Qs = (LAS bf16*)C.lds; LAS bf16* Ks = (LAS bf16*)(C.lds + 17408); LAS bf16* VT = (LAS bf16*)(C.lds + 34816); LAS bf16* P = (LAS bf16*)(C.lds + 71680);
    LAS float* bv = (LAS float*)(C.lds + 80896); LAS float* igv = bv + 64; LAS float* eb = bv + 128; LAS float* den = bv + 192; LAS float* nv = bv + 256;
    LAS float* Hb = (LAS float*)C.lds;
    const int lane = C.lane, wave = C.wave, tid = C.tid, fr = lane & 15, fq = lane >> 4;
    for (int unit = C.bid; unit < MH * NCH; unit += C.G) {
        const int h = unit >> 8, c = unit & 255, row0 = c * CH;
        if (wave == 0) { const float lf = LOGF[h * M + row0 + lane], ig = IG[h * M + row0 + lane]; const float b = incl_scan64(lf, lane);
            bv[lane] = b; igv[lane] = ig; eb[lane] = __expf(b); den[lane] = 0.f; }
        if (wave == 1) { nv[lane] = NST[unit * DQK + lane]; nv[lane + 64] = NST[unit * DQK + 64 + lane]; }
        bf16x8 ctf[4][2]; u32x2 mov[8];
        { const bf16* CTu = CT + (size_t)unit * (DV * DQK);
#pragma unroll
          for (int ks = 0; ks < 4; ++ks)
#pragma unroll
            for (int ci = 0; ci < 2; ++ci) ctf[ks][ci] = *(const bf16x8*)(CTu + ((2 * wave + ci) * 16 + fr) * DQK + 32 * ks + 8 * fq);
#pragma unroll
          for (int i = 0; i < 8; ++i) mov[i] = *(const u32x2*)(PROJ + (size_t)(row0 + 8 * wave + i) * NPROJ + PC_MO + h * DV + 4 * lane); }
        const f32x4 gmn = *(const f32x4*)(mnorm_g + h * DV + 4 * lane);
        { const int tens = tid >> 8, rgrp = (tid >> 4) & 15, cg = tid & 15; float y[4][8];
          conv_rows<4>(PROJ, conv_w, conv_b, tens * 512 + h * DQK + 8 * cg, row0 + 4 * rgrp, tens ? 1.0f : 0.08838834764831845f, y);
          LAS bf16* dst = tens ? Ks : Qs;
#pragma unroll
          for (int r = 0; r < 4; ++r) *(LAS u32x4*)(dst + (4 * rgrp + r) * QKS + 8 * cg) = (u32x4){pk2(y[r][0], y[r][1]), pk2(y[r][2], y[r][3]), pk2(y[r][4], y[r][5]), pk2(y[r][6], y[r][7])}; }
        stage_vt(VT, PROJ, row0, PC_MV + h * DV, wave, lane);
        __syncthreads();
        { const int tr = wave >> 1;
#pragma unroll
          for (int cc = 0; cc < 2; ++cc) { const int tc = 2 * (wave & 1) + cc; const int s = tc * 16 + fr;
            if (tc <= tr) {
                f32x4 acc = (f32x4){0.f, 0.f, 0.f, 0.f};
#pragma unroll
                for (int ks = 0; ks < 4; ++ks) { const bf16x8 a = *(const LAS bf16x8*)(Qs + (tr * 16 + fr) * QKS + 32 * ks + 8 * fq), b = *(const LAS bf16x8*)(Ks + (tc * 16 + fr) * QKS + 32 * ks + 8 * fq);
                    acc = __builtin_amdgcn_mfma_f32_16x16x32_bf16(a, b, acc, 0, 0, 0); }
                const float bs = bv[s], is = igv[s];
#pragma unroll
                for (int j = 0; j < 4; ++j) { const int t = tr * 16 + 4 * fq + j; float p = (s <= t) ? acc[j] * __expf(bv[t] - bs + is) : 0.f;
                    P[t * VTS + s] = (bf16)(pk2(p, 0.f) & 0xffffu);
                    p += __shfl_xor(p, 1); p += __shfl_xor(p, 2); p += __shfl_xor(p, 4); p += __shfl_xor(p, 8);
                    if (fr == 0) unsafeAtomicAdd((float*)&den[t], p); }
            } else {
#pragma unroll
                for (int j = 0; j < 4; ++j) P[(tr * 16 + 4 * fq + j) * VTS + s] = (bf16)0;
            } } }
        { const int t = tid >> 3, part = tid & 7; float s = 0.f;
#pragma unroll
          for (int d = 0; d < 16; ++d) s += bf2f(Qs[t * QKS + 16 * part + d]) * nv[16 * part + d];
          s += __shfl_xor(s, 1); s += __shfl_xor(s, 2); s += __shfl_xor(s, 4);
          if (part == 0) unsafeAtomicAdd((float*)&den[t], eb[t] * s); }
        __syncthreads();
        f32x4 hv[4][2];
        { f32x4 accI[4][2], accP[4][2];
#pragma unroll
          for (int rt = 0; rt < 4; ++rt)
#pragma unroll
            for (int ci = 0; ci < 2; ++ci) { accI[rt][ci] = (f32x4){0.f, 0.f, 0.f, 0.f}; accP[rt][ci] = (f32x4){0.f, 0.f, 0.f, 0.f}; }
#pragma unroll
          for (int ks = 0; ks < 4; ++ks) {
#pragma unroll
            for (int rt = 0; rt < 4; ++rt) { const bf16x8 a = *(const LAS bf16x8*)(Qs + (rt * 16 + fr) * QKS + 32 * ks + 8 * fq);
#pragma unroll
                for (int ci = 0; ci < 2; ++ci) accI[rt][ci] = __builtin_amdgcn_mfma_f32_16x16x32_bf16(a, ctf[ks][ci], accI[rt][ci], 0, 0, 0); } }
#pragma unroll
          for (int ks = 0; ks < 2; ++ks) { bf16x8 b[2];
#pragma unroll
            for (int ci = 0; ci < 2; ++ci) b[ci] = *(const LAS bf16x8*)(VT + ((2 * wave + ci) * 16 + fr) * VTS + 32 * ks + 8 * fq);
#pragma unroll
            for (int rt = 0; rt < 4; ++rt) { const bf16x8 a = *(const LAS bf16x8*)(P + (rt * 16 + fr) * VTS + 32 * ks + 8 * fq);
#pragma unroll
                for (int ci = 0; ci < 2; ++ci) accP[rt][ci] = __builtin_amdgcn_mfma_f32_16x16x32_bf16(a, b[ci], accP[rt][ci], 0, 0, 0); } }
#pragma unroll
          for (int rt = 0; rt < 4; ++rt)
#pragma unroll
            for (int j = 0; j < 4; ++j) { const int t = rt * 16 + 4 * fq + j; const float e = eb[t], dn = 1.0f / fmaxf(fabsf(den[t]), 1.0f);
#pragma unroll
                for (int ci = 0; ci < 2; ++ci) hv[rt][ci][j] = (e * accI[rt][ci][j] + accP[rt][ci][j]) * dn; } }
        __syncthreads();
#pragma unroll
        for (int rt = 0; rt < 4; ++rt)
#pragma unroll
            for (int ci = 0; ci < 2; ++ci)
#pragma unroll
                for (int j = 0; j < 4; ++j) Hb[(rt * 16 + 4 * fq + j) * 260 + (2 * wave + ci) * 16 + fr] = hv[rt][ci][j];
        __syncthreads();
#pragma unroll
        for (int i = 0; i < 8; ++i) { const int t = 8 * wave + i;
            const f32x4 v = *(const LAS f32x4*)(Hb + t * 260 + 4 * lane);
            const float ss = wave_sum((v.x * v.x + v.y * v.y) + (v.z * v.z + v.w * v.w));
            const float rs = 1.0f / sqrtf(ss * (1.0f / DV) + EPS);
            const f32x4 g = gmn; const u32x2 mo = mov[i];
            const float o0 = v.x * rs * g.x * sigmoidf_(bf2f(mo.x & 0xffffu)), o1 = v.y * rs * g.y * sigmoidf_(bf2f(mo.x >> 16));
            const float o2 = v.z * rs * g.z * sigmoidf_(bf2f(mo.y & 0xffffu)), o3 = v.w * rs * g.w * sigmoidf_(bf2f(mo.y >> 16));
            u32x2 w; w.x = pk2(o0, o1); w.y = pk2(o2, o3);
            *(u32x2*)(CAT + (size_t)(row0 + t) * DM + h * DV + 4 * lane) = w; }
        __syncthreads();
    }
}
}

__device__ __forceinline__ void attn_combine(const Ctx& C, const Args& A) {
    const bf16* AO = (const bf16*)(C.ws + WS_ATTO); bf16* CAT = (bf16*)(C.ws + WS_CAT);
    const int lane = C.lane;
    const float l1 = wave_sum(A.in[8][lane] * A.in[9][lane]), l2 = wave_sum(A.in[10][lane] * A.in[11][lane]);
    const float lam = expf(l1) - expf(l2) + LAM_INIT;
    const int h = lane >> 3, part = lane & 7;
    float g[16];
#pragma unroll
    for (int q = 0; q < 4; ++q) { const f32x4 t = *(const f32x4*)(A.in[12] + 16 * part + 4 * q); g[4 * q] = t.x * (1.0f - LAM_INIT); g[4 * q + 1] = t.y * (1.0f - LAM_INIT); g[4 * q + 2] = t.z * (1.0f - LAM_INIT); g[4 * q + 3] = t.w * (1.0f - LAM_INIT); }
    const int gw = C.bid * 8 + C.wave, NGW = C.G * 8;
    for (int t0 = gw; t0 < M; t0 += 2 * NGW) {
        u32x4 a[2][2], b[2][2];
#pragma unroll
        for (int rr = 0; rr < 2; ++rr) { const int t = t0 + rr * NGW; if (t < M) { const bf16* p = AO + (size_t)t * DM + h * 256 + 16 * part;
            a[rr][0] = *(const u32x4*)p; a[rr][1] = *(const u32x4*)(p + 8); b[rr][0] = *(const u32x4*)(p + 128); b[rr][1] = *(const u32x4*)(p + 136); } }
#pragma unroll
        for (int rr = 0; rr < 2; ++rr) { const int t = t0 + rr * NGW; if (t < M) {
            float d[16]; float ss = 0.f;
#pragma unroll
            for (int q = 0; q < 2; ++q)
#pragma unroll
                for (int k = 0; k < 4; ++k) { const unsigned wa = a[rr][q][k], wb = b[rr][q][k];
                    const float d0 = bf2f(wa & 0xffffu) - lam * bf2f(wb & 0xffffu), d1 = bf2f(wa >> 16) - lam * bf2f(wb >> 16);
                    d[8 * q + 2 * k] = d0; d[8 * q + 2 * k + 1] = d1; ss += d0 * d0 + d1 * d1; }
            ss += __shfl_xor(ss, 1); ss += __shfl_xor(ss, 2); ss += __shfl_xor(ss, 4);
            const float rs = 1.0f / sqrtf(ss * (1.0f / 128.0f) + EPS);
            u32x4 o0, o1;
#pragma unroll
            for (int k = 0; k < 4; ++k) { o0[k] = pk2(d[2 * k] * rs * g[2 * k], d[2 * k + 1] * rs * g[2 * k + 1]); o1[k] = pk2(d[8 + 2 * k] * rs * g[8 + 2 * k], d[9 + 2 * k] * rs * g[9 + 2 * k]); }
            bf16* q = CAT + (size_t)t * DM + 1024 + h * 128 + 16 * part; *(u32x4*)q = o0; *(u32x4*)(q + 8) = o1; } }
    }
}

#define XB_TMO      128
#define XB_XCNT(j)  (256  + 64 * (j))
#define XB_XSUB(j)  (1280 + 64 * (j))
#define XB_XGEN(j)  (2304 + 64 * (j))
#define XB_TOP      3328
#define XB_TOPGEN   3392
#define XCD_BAR_WORDS 3456
#define XB_SPIN_CAP (1u << 18)

__device__ __forceinline__ unsigned xb_ld(unsigned* p)              { return __hip_atomic_load(p, __ATOMIC_RELAXED, __HIP_MEMORY_SCOPE_AGENT); }
__device__ __forceinline__ unsigned xb_add(unsigned* p, unsigned v) { return __hip_atomic_fetch_add(p, v, __ATOMIC_RELAXED, __HIP_MEMORY_SCOPE_AGENT); }
__device__ __forceinline__ unsigned xb_xcc_id() { return (unsigned)__builtin_amdgcn_s_getreg((3 << 11) | 20) & 0xFu; }
#define XB_SPIN(cond, bar) do { unsigned _sp = 0; while (cond) { __builtin_amdgcn_s_sleep(1); \
    if ((++_sp & 255u) == 0u) { if (xb_ld(&(bar)[XB_TMO])) break; if (_sp > XB_SPIN_CAP) { atomicAdd(&(bar)[XB_TMO], 1u); break; } } } } while (0)

struct XcdBarrier {
    unsigned* bar; unsigned x;
    volatile LAS unsigned* st;
};

__device__ __forceinline__ XcdBarrier xcd_barrier_post(unsigned* bar, volatile LAS unsigned* st) {
    XcdBarrier b; b.bar = bar; b.x = xb_xcc_id(); b.st = st;
    if (threadIdx.x == 0) (void)xb_add(&bar[XB_XCNT(b.x)], 1u);
    return b;
}
__device__ __forceinline__ void xcd_barrier_complete(unsigned* bar, unsigned x, unsigned& nloc, unsigned& nx) {
    const unsigned G = gridDim.x * gridDim.y * gridDim.z;
    unsigned sum, cnt, mine, sp = 0u;
    for (;;) {
        sum = 0u; cnt = 0u; mine = 0u;
#pragma unroll
        for (unsigned j = 0; j < 16; ++j) { const unsigned c = xb_ld(&bar[XB_XCNT(j)]); sum += c; cnt += (c > 0u) ? 1u : 0u; mine = (j == x) ? c : mine; }
        if (sum == G) break;
        __builtin_amdgcn_s_sleep(1);
        if ((++sp & 255u) == 0u) { if (xb_ld(&bar[XB_TMO])) break; if (sp > XB_SPIN_CAP) { atomicAdd(&bar[XB_TMO], 1u); break; } }
    }
    nloc = mine > 0u ? mine : 1u; nx = cnt > 0u ? cnt : 1u;
}

__device__ __forceinline__ void xcd_barrier(const XcdBarrier& b) {
    asm volatile("s_waitcnt vmcnt(0)" ::: "memory");
    __syncthreads();
    if (threadIdx.x == 0) {
        unsigned* bar = b.bar;
        __builtin_amdgcn_s_waitcnt(0);
        unsigned nloc = b.st[0], nx = b.st[1];
        if (nloc == 0u) { xcd_barrier_complete(bar, b.x, nloc, nx); b.st[0] = nloc; b.st[1] = nx; }
        const unsigned old = xb_add(&bar[XB_XSUB(b.x)], 1u);
        const unsigned gen = old / nloc;
        if (old + 1u == (gen + 1u) * nloc) {
            __builtin_amdgcn_fence(__ATOMIC_RELEASE, "agent");
            asm volatile("s_waitcnt vmcnt(0)" ::: "memory");
            const unsigned og = xb_add(&bar[XB_TOP], 1u);
            const unsigned tg = og / nx;
            if (og + 1u == (tg + 1u) * nx) xb_add(&bar[XB_TOPGEN], 1u);
            else XB_SPIN(xb_ld(&bar[XB_TOPGEN]) == tg, bar);
            __builtin_amdgcn_fence(__ATOMIC_ACQUIRE, "agent");
            xb_add(&bar[XB_XGEN(b.x)], 1u);
            asm volatile("s_waitcnt vmcnt(0)" ::: "memory");
        } else {
            XB_SPIN(xb_ld(&bar[XB_XGEN(b.x)]) == gen, bar);
            __builtin_amdgcn_fence(__ATOMIC_ACQUIRE, "agent");
            asm volatile("s_waitcnt vmcnt(0)" ::: "memory");
        }
    }
    __syncthreads();
}

__global__ void __launch_bounds__(512, 2) fwd_megakernel(Args args) {
    __builtin_assume(__builtin_amdgcn_workitem_id_y() == 0); __builtin_assume(__builtin_amdgcn_workitem_id_z() == 0);
    extern __shared__ __attribute__((aligned(16))) unsigned char lds[];
    cg::grid_group grid = cg::this_grid();
#define MKCTX() Ctx C; { int t_ = threadIdx.x; asm volatile("" : "+v"(t_)); C.lds = (LAS unsigned char*)lds; C.tid = t_; C.lane = t_ & 63; C.wave = __builtin_amdgcn_readfirstlane(t_ >> 6); C.G = gridDim.x; C.bid = blockIdx.x; C.ws = args.ws; }
    unsigned char* const wsb = args.ws; const int G_ = gridDim.x, bid_ = blockIdx.x;
    const int lo = args.ph_lo, hi = args.ph_hi;
    volatile LAS unsigned* bst = (volatile LAS unsigned*)((LAS unsigned char*)lds + 147392);
    if (threadIdx.x < 16) bst[threadIdx.x] = 0u;
    __syncthreads();
    const XcdBarrier bar = xcd_barrier_post((unsigned*)(args.ws + WS_BAR), bst);
    if (hi > 1000) grid.sync();
#define IN(k) (lo <= (k) && (k) < hi)
#define SEAM(k) do { if (IN(k) && IN((k) + 1)) xcd_barrier(bar); } while (0)
    const float* x = args.in[0];
    bf16* XN = (bf16*)(wsb + WS_XN); bf16* PROJ = (bf16*)(wsb + WS_PROJ); bf16* CAT = (bf16*)(wsb + WS_CAT); bf16* ACT = (bf16*)(wsb + WS_ACT);

    if (IN(0)) { MKCTX();
        LAS float* wg = (LAS float*)C.lds;
        for (int i = C.tid; i < 8 * DM; i += 512) { const int k = i >> 3, q = i & 7; wg[q * DM + k] = args.in[2][(size_t)k * 6152 + 3072 + q]; }
        __syncthreads();
        rows_pass<0>(C, x, args.in[1], XN, nullptr, wg, args.in[5], args.in[6]);
        { float* TAB = (float*)(C.ws + WS_TAB);
          for (int i = C.bid * 512 + C.tid; i < M * 32; i += C.G * 512) { const int t = i >> 5, d = i & 31; const float ang = (float)t * args.inv[d];
              double rev = (double)ang * 0.15915494309189535; rev -= rint(rev); const float fr = (float)rev; TAB[2 * i] = __builtin_amdgcn_cosf(fr); TAB[2 * i + 1] = __builtin_amdgcn_sinf(fr); } }
        __syncthreads();
        p0_weights<0>(C, args.in[2], args.in[13], args.in[15], args.in[16], args.in[17]);
        __syncthreads();
    }
    SEAM(0);
    if (IN(1)) { MKCTX();
        pg8::Gemm g{XN, (const bf16*)(C.ws + WS_WIN), M, NPROJ, DM}; pg8::StaticOrder S; S.init(M, NPROJ, C.G, C.bid);
        pg8::EpiProj E{PROJ, NPROJ, (const float*)(C.ws + WS_TAB), 0.125f * 1.4426950408889634f};
        const int lateq = (C.bid >> 3) & 3;
        if (lateq == 0) { p0_weights<1>(C, args.in[2], args.in[13], args.in[15], args.in[16], args.in[17]); __syncthreads(); }
        pg8::gemm_phase<pg8::EpiProj, pg8::StaticOrder, PG8_ALIGN, PG8_SP2>(C.lds, g, S, E);
        if (lateq == 1) { __syncthreads(); p0_weights<1>(C, args.in[2], args.in[13], args.in[15], args.in[16], args.in[17]); __syncthreads(); }
    }
    SEAM(1);
    if (IN(2)) {
        const attn128::AttnTensors AT{(const attn128::bf16*)PROJ, (attn128::bf16*)(wsb + WS_ATTO)};
        const bool m1_last = ((bid_ >> 3) & 1) != 0; const int lateq = (bid_ >> 3) & 3;
        if (lateq == 2) { { MKCTX(); p0_weights<1>(C, args.in[2], args.in[13], args.in[15], args.in[16], args.in[17]); } __syncthreads(); }
        if (!m1_last) { { MKCTX(); ml::m1_phase(C, args.out, args.in[3], args.in[4]); } __syncthreads(); }
        attn128::attn_phase<8>((char*)lds, AT, G_, bid_);
        if (m1_last) { __syncthreads(); { MKCTX(); ml::m1_phase(C, args.out, args.in[3], args.in[4]); } }
        if (lateq == 3) { __syncthreads(); { MKCTX(); p0_weights<1>(C, args.in[2], args.in[13], args.in[15], args.in[16], args.in[17]); } __syncthreads(); }
    }
    SEAM(2);
    if (IN(3)) { MKCTX(); ml::m2_scan(C, args.out); }
    SEAM(3);
    if (IN(4)) {
        if ((bid_ >> 3) & 1) { { MKCTX(); attn_combine(C, args); } __syncthreads(); { MKCTX(); ml::m3_phase(C, args.in[7], args.in[3], args.in[4]); } }
        else { { MKCTX(); ml::m3_phase(C, args.in[7], args.in[3], args.in[4]); } { MKCTX(); attn_combine(C, args); } } }
    SEAM(4);
    if (IN(5)) { MKCTX();
        pg8::Gemm g{CAT, (const bf16*)(C.ws + WS_WOUT), M, DM, DM}; pg8::StaticOrder S; S.init(M, DM, C.G, C.bid);
        pg8::EpiBf16<0> E{(bf16*)(C.ws + WS_CT), DM, nullptr, 0, 0, 1.f};
        pg8::gemm_phase<pg8::EpiBf16<0>, pg8::StaticOrder, PG8_ALIGN, PG8_SP2>(C.lds, g, S, E);
    }
    SEAM(5);
    if (IN(6)) { MKCTX(); rows_pass<1>(C, x, args.in[14], XN, nullptr, nullptr, nullptr, nullptr, (const bf16*)(C.ws + WS_CT), nullptr); }
    SEAM(6);
    if (IN(7)) { MKCTX();
        pg8::Gemm g{XN, (const bf16*)(C.ws + WS_WGU), M, NGU, DM}; pg8::StaticOrder S; S.init(M, NGU, C.G, C.bid);
        pg8::EpiSwiGLU E{ACT, FF};
        pg8::gemm_phase<pg8::EpiSwiGLU, pg8::StaticOrder, PG8_ALIGN, PG8_SP2>(C.lds, g, S, E);
    }
    SEAM(7);
    if (IN(8)) { MKCTX();
        pg8::Gemm g{ACT, (const bf16*)(C.ws + WS_WD), M, DM, FF}; pg8::StaticOrder S; S.init(M, DM, C.G, C.bid);
        pg8::EpiBf16<0> E{CAT, DM, nullptr, 0, 0, 1.f};
        pg8::gemm_phase<pg8::EpiBf16<0>, pg8::StaticOrder, PG8_ALIGN, PG8_SP2>(C.lds, g, S, E);
    }
    SEAM(8);
    if (IN(9)) { MKCTX(); rows_pass<2>(C, x, args.in[18], nullptr, args.out, nullptr, nullptr, nullptr, (const bf16*)(C.ws + WS_CT), CAT); }
#undef IN
#undef SEAM
}

#ifndef MK_N_LAUNCHES
#define MK_N_LAUNCHES 1
#endif
extern "C" void kernel_launch(void* const* d_in, const int* in_sizes, int n_in, void* d_out, int out_size, void* d_ws, size_t ws_size, hipStream_t stream) {
    static int grid = 0;
    if (grid == 0) {
        if (n_in != 19 || in_sizes[0] != M * DM || out_size != M * DM || ws_size < WS_END) { fprintf(stderr, "kernel_launch: unexpected shapes: n_in %d in0 %d out %d ws %zu (need %zu); nothing launched\n", n_in, n_in > 0 ? in_sizes[0] : -1, out_size, ws_size, (size_t)WS_END); grid = -1; return; }
        int dev = 0, cus = 0, per_cu = 0;
        if (hipGetDevice(&dev) != hipSuccess || hipDeviceGetAttribute(&cus, hipDeviceAttributeMultiprocessorCount, dev) != hipSuccess) { grid = -1; return; }
        if (hipFuncSetAttribute((const void*)fwd_megakernel, hipFuncAttributeMaxDynamicSharedMemorySize, LDS_BYTES) != hipSuccess) { fprintf(stderr, "kernel_launch: hipFuncSetAttribute failed\n"); grid = -1; return; }
        if (hipOccupancyMaxActiveBlocksPerMultiprocessor(&per_cu, (const void*)fwd_megakernel, 512, LDS_BYTES) != hipSuccess || per_cu < 1) { fprintf(stderr, "kernel_launch: occupancy query says %d\n", per_cu); per_cu = 1; }
        (void)hipGetLastError();
        grid = cus * per_cu;
        fprintf(stderr, "kernel_launch: grid %d (cus %d x %d), ws %zu MiB\n", grid, cus, per_cu, ws_size >> 20);
    }
    if (grid < 0) return;
    Args a{};
    for (int i = 0; i < 19; ++i) a.in[i] = (const float*)d_in[i];
    a.out = (float*)d_out; a.ws = (unsigned char*)d_ws;
    for (int d = 0; d < 32; ++d) a.inv[d] = (float)pow(10000.0, -(double)d / 32.0);
    if (hipMemsetAsync((char*)d_ws + WS_BAR, 0, 16384, stream) != hipSuccess) { fprintf(stderr, "kernel_launch: memset of the barrier words failed\n"); return; }
    if (MK_N_LAUNCHES == 1) {
        a.ph_lo = 0; a.ph_hi = 10;
        void* kargs[] = {&a};
        hipError_t e = hipLaunchCooperativeKernel((const void*)fwd_megakernel, dim3(grid), dim3(512), kargs, LDS_BYTES, stream);
        if (e != hipSuccess) fprintf(stderr, "cooperative launch failed: %s (grid %d)\n", hipGetErrorString(e), grid);
    } else {
        for (int p = 0; p < 10; ++p) { a.ph_lo = p; a.ph_hi = p + 1; hipLaunchKernelGGL(fwd_megakernel, dim3(grid), dim3(512), LDS_BYTES, stream, a); }
    }
}
```

```cpp
#include <hip/hip_runtime.h>
#include <hip/hip_cooperative_groups.h>
#include <cstdio>
#include <cstdint>
#include <cmath>
namespace cg = cooperative_groups;
namespace pg8 {
#define PG8_LAS __attribute__((address_space(3)))
typedef unsigned short bf16_t;
typedef short bf16x8 __attribute__((ext_vector_type(8)));
typedef float f32x4 __attribute__((ext_vector_type(4)));
typedef unsigned u32x4 __attribute__((ext_vector_type(4)));
constexpr int BM = 256, BK = 64, HALF = 128, HTB = HALF * BK * 2  , STAGE_BYTES = 8 * HTB, NXCD = 8, WGM = 8;

__host__ __device__ __forceinline__ int lds_byte(int r, int c) { const int st = (r >> 4) * 2 + (c >> 5), rr = r & 15, cc = c & 31, ob = rr * 64 + cc * 2; return st * 1024 + (ob ^ (((ob >> 9) & 1) << 5)); }
__host__ __device__ __forceinline__ void stage_rc(int b, int& R, int& C) { const int st = b / 1024, sb = b % 1024, swz = sb ^ (((sb >> 9) & 1) << 5); R = (st >> 1) * 16 + swz / 64; C = (st & 1) * 32 + (swz % 64) / 2; }
__host__ __device__ __forceinline__ int perm32(int rho) { const int n = rho >> 4, i = rho & 15; return 8 * (i >> 2) + 4 * n + (i & 3); }

struct Unit { int pm, pn; };
struct Gemm { const bf16_t* A; const bf16_t* Bt; int M, N, K; };

struct StaticOrder {
    int nM, nN, nwg, G, c;
    __host__ __device__ void init(int M, int N, int G_, int c_) { nM = M / BM; nN = N / BM; nwg = nM * nN; G = G_; c = c_; }
    __host__ __device__ bool next(int i, Unit& u) const {
        const long L = (long)i * G + c; if (L >= nwg) return false;
        int wgid = (int)L; { const int q = nwg / NXCD, r = nwg % NXCD, xcd = wgid % NXCD, off = wgid / NXCD; wgid = (xcd < r ? xcd * (q + 1) : r * (q + 1) + (xcd - r) * q) + off; }
        const int nig = WGM * nN, gid = wgid / nig, fm = gid * WGM, gsz = (nM - fm) < WGM ? (nM - fm) : WGM;
        u.pm = fm + ((wgid % nig) % gsz); u.pn = (wgid % nig) / gsz; return true;
    }
    __device__ __forceinline__ void a_ready(const Unit&) const {}
    __device__ __forceinline__ void done(const Unit&) const {}
};

__device__ __forceinline__ unsigned cvt_pk_bf16(float lo, float hi) { unsigned r; asm volatile("v_cvt_pk_bf16_f32 %0, %1, %2" : "=v"(r) : "v"(lo), "v"(hi)); return r; }
typedef float f32x2 __attribute__((ext_vector_type(2)));
__device__ __forceinline__ f32x2 gelu_pk(f32x2 v) {
    const f32x2 av = __builtin_elementwise_abs(v), d = av * 0.2316418882f + 1.0f;
    f32x2 t; t.x = __builtin_amdgcn_rcpf(d.x); t.y = __builtin_amdgcn_rcpf(d.y);
    f32x2 q = t * 0.5307027145f + (-0.7265760135f); q = q * t + 0.7107068705f; q = q * t + (-0.142248368f); q = q * t + 0.127414796f; q = q * t;
    const f32x2 s = (v * v) * (-0.72134752044f);
    f32x2 e; e.x = __builtin_amdgcn_exp2f(s.x); e.y = __builtin_amdgcn_exp2f(s.y);
    const f32x2 m = v * (q * e), r = v - m;
    f32x2 o; o.x = v.x < 0.f ? m.x : r.x; o.y = v.y < 0.f ? m.y : r.y; return o;
}

template <int ACT  > struct EpiBf16 {
    static constexpr bool PERM = true, AFTER_DRAIN = false; static_assert(ACT == 0 || ACT == 1, "EpiBf16: ACT is 0 (none) or 1 (gelu_pk)");
    bf16_t* O; int ldc; const float* bias; int split_cols; size_t split_stride; float scale0;
    __device__ __forceinline__ void operator()(const f32x4 (&acc)[2][2][4][2], const Unit& u, int wr, int wc, int fr, int fq) const {
        const int row0 = u.pm * BM + wr * 64 + fr; int colt = u.pn * BM; bf16_t* base = O;
        float sc = 1.f; if (split_cols) { const int t = colt / split_cols; base += (size_t)t * split_stride; colt -= t * split_cols; if (t == 0) sc = scale0; }
        const int col0 = colt + wc * 32 + 8 * fq, bcol0 = u.pn * BM + wc * 32 + 8 * fq;
        f32x4 bv[2][2];
#pragma unroll
        for (int bj = 0; bj < 2; ++bj)
#pragma unroll
            for (int n = 0; n < 2; ++n) bv[bj][n] = bias ? *(const f32x4*)(bias + bcol0 + bj * HALF + 4 * n) : (f32x4){0.f, 0.f, 0.f, 0.f};
#pragma unroll
        for (int ai = 0; ai < 2; ++ai)
#pragma unroll
            for (int m = 0; m < 4; ++m) { bf16_t* rowp = base + (size_t)(row0 + ai * HALF + m * 16) * ldc + col0;
#pragma unroll
                for (int bj = 0; bj < 2; ++bj) { f32x4 v0 = acc[ai][bj][m][0] + bv[bj][0], v1 = acc[ai][bj][m][1] + bv[bj][1];
                    if (ACT == 1) { f32x2 a = gelu_pk((f32x2){v0[0], v0[1]}), b = gelu_pk((f32x2){v0[2], v0[3]}), c = gelu_pk((f32x2){v1[0], v1[1]}), d = gelu_pk((f32x2){v1[2], v1[3]});
                        v0 = (f32x4){a.x, a.y, b.x, b.y}; v1 = (f32x4){c.x, c.y, d.x, d.y}; }
                    v0 = v0 * sc; v1 = v1 * sc; u32x4 w; w.x = cvt_pk_bf16(v0[0], v0[1]); w.y = cvt_pk_bf16(v0[2], v0[3]); w.z = cvt_pk_bf16(v1[0], v1[1]); w.w = cvt_pk_bf16(v1[2], v1[3]);
                    *(u32x4*)(rowp + bj * HALF) = w; } }
    }
};
struct EpiProj {
    static constexpr bool PERM = true, AFTER_DRAIN = false;
    bf16_t* O; int ldc; const float* tab; float scale_q;
    __device__ __forceinline__ void operator()(const f32x4 (&acc)[2][2][4][2], const Unit& u, int wr, int wc, int fr, int fq) const {
        const int row0 = u.pm * BM + wr * 64 + fr, col0 = u.pn * BM + wc * 32 + 8 * fq;
        const bool rope = (u.pn >= 12 && u.pn < 20); const float sc = (u.pn >= 12 && u.pn < 16) ? scale_q : 1.0f;
        asm volatile("s_nop 15" ::: "memory");
#pragma unroll
        for (int ai = 0; ai < 2; ++ai)
#pragma unroll
            for (int m = 0; m < 4; ++m) { const int row = row0 + ai * HALF + m * 16; bf16_t* rowp = O + (size_t)row * ldc + col0;
#pragma unroll
                for (int bj = 0; bj < 2; ++bj) { f32x4 v0 = acc[ai][bj][m][0], v1 = acc[ai][bj][m][1];
                    if (rope) { const int dp = ((col0 + bj * HALF) & 63) >> 1;
                        const f32x4 cs0 = *(const f32x4*)(tab + ((size_t)row * 32 + dp) * 2), cs1 = *(const f32x4*)(tab + ((size_t)row * 32 + dp + 2) * 2);
                        const f32x4 a = v0, b = v1;
                        v0[0] = (a[0] * cs0[0] - a[1] * cs0[1]) * sc; v0[1] = (a[1] * cs0[0] + a[0] * cs0[1]) * sc; v0[2] = (a[2] * cs0[2] - a[3] * cs0[3]) * sc; v0[3] = (a[3] * cs0[2] + a[2] * cs0[3]) * sc;
                        v1[0] = (b[0] * cs1[0] - b[1] * cs1[1]) * sc; v1[1] = (b[1] * cs1[0] + b[0] * cs1[1]) * sc; v1[2] = (b[2] * cs1[2] - b[3] * cs1[3]) * sc; v1[3] = (b[3] * cs1[2] + b[2] * cs1[3]) * sc; }
                    u32x4 w; w.x = cvt_pk_bf16(v0[0], v0[1]); w.y = cvt_pk_bf16(v0[2], v0[3]); w.z = cvt_pk_bf16(v1[0], v1[1]); w.w = cvt_pk_bf16(v1[2], v1[3]);
                    *(u32x4*)(rowp + bj * HALF) = w; } }
    }
};
struct EpiResF32 {
    static constexpr bool PERM = false, AFTER_DRAIN = false;
    const float* base; float* out; int ldc;
    __device__ __forceinline__ void operator()(const f32x4 (&acc)[2][2][4][2], const Unit& u, int wr, int wc, int fr, int fq) const {
        const int row0 = u.pm * BM + wr * 64 + fr, col0 = u.pn * BM + wc * 32 + 4 * fq;
#pragma unroll
        for (int ai = 0; ai < 2; ++ai)
#pragma unroll
            for (int m = 0; m < 4; ++m) { const size_t off = (size_t)(row0 + ai * HALF + m * 16) * ldc + col0;
#pragma unroll
                for (int bj = 0; bj < 2; ++bj)
#pragma unroll
                    for (int n = 0; n < 2; ++n) { const f32x4 b = *(const f32x4*)(base + off + bj * HALF + n * 16); *(f32x4*)(out + off + bj * HALF + n * 16) = b + acc[ai][bj][m][n]; } }
    }
};
struct EpiSwiGLU {
    static constexpr bool PERM = true, AFTER_DRAIN = false;
    bf16_t* O; int ldc;
    __device__ __forceinline__ void operator()(const f32x4 (&acc)[2][2][4][2], const Unit& u, int wr, int wc, int fr, int fq) const {
        const int row0 = u.pm * BM + wr * 64 + fr, col0 = u.pn * HALF + wc * 32 + 8 * fq;
#pragma unroll
        for (int ai = 0; ai < 2; ++ai)
#pragma unroll
            for (int m = 0; m < 4; ++m) { bf16_t* rowp = O + (size_t)(row0 + ai * HALF + m * 16) * ldc + col0;
                float r[8];
#pragma unroll
                for (int n = 0; n < 2; ++n)
#pragma unroll
                    for (int i = 0; i < 4; ++i) { const float g = acc[ai][0][m][n][i], up = acc[ai][1][m][n][i]; r[4 * n + i] = g * __builtin_amdgcn_rcpf(1.0f + __expf(-g)) * up; }
                u32x4 w; w.x = cvt_pk_bf16(r[0], r[1]); w.y = cvt_pk_bf16(r[2], r[3]); w.z = cvt_pk_bf16(r[4], r[5]); w.w = cvt_pk_bf16(r[6], r[7]);
                *(u32x4*)rowp = w; }
    }
};
template <class Epi, class Sched, bool ALIGN_EPI = false, bool SP2 = false>
__device__ __forceinline__ void gemm_phase(PG8_LAS unsigned char* lds, const Gemm g, const Sched& S, const Epi& E) {
    int tid_ = threadIdx.x; asm volatile("" : "+v"(tid_));
    const int tid = tid_, wid = __builtin_amdgcn_readfirstlane(tid >> 6), lane = tid & 63, wr = wid >> 2, wc = wid & 3, fr = lane & 15, fq = lane >> 4;
    const int K = g.K, nt = K / BK;
    unsigned voffA[2], voffB[2];
#pragma unroll
    for (int i = 0; i < 2; ++i) { int R, C; stage_rc(tid * 16 + i * 8192, R, C); const int Rb = Epi::PERM ? ((R & ~31) + perm32(R & 31)) : R;
        voffA[i] = (unsigned)(R * K + C) * 2u; voffB[i] = (unsigned)(Rb * K + C) * 2u; }
    const size_t kstep = (size_t)(BK * 2);
    const size_t hstep = (size_t)HALF * K * 2;
    const size_t tstep = 2 * hstep;
    const unsigned ldsw = (unsigned)wid * 1024u;
    const int aoff = lds_byte(wr * 64 + fr, fq * 8), boff = lds_byte(wc * 32 + fr, fq * 8);
#define PG8_SA(b, h) (((b) * 2 + (h)) * HTB)
#define PG8_SB(b, h) ((4 + (b) * 2 + (h)) * HTB)
#define PG8_STAGE(bufoff, gbase, voff) do { _Pragma("unroll") for (int _i = 0; _i < 2; ++_i) \
        __builtin_amdgcn_global_load_lds((const unsigned*)((const char*)(gbase) + (voff)[_i]), (PG8_LAS unsigned*)(lds + (bufoff) + ldsw + _i * 8192), 16, 0, 0); } while (0)
#define PG8_LDA(dst, b, h) do { _Pragma("unroll") for (int m = 0; m < 4; ++m) _Pragma("unroll") for (int k = 0; k < 2; ++k) dst[m][k] = *(const PG8_LAS bf16x8*)(lds + PG8_SA(b, h) + aoff + m * 2048 + k * 1024); } while (0)
#define PG8_LDB(dst, b, h) do { _Pragma("unroll") for (int n = 0; n < 2; ++n) _Pragma("unroll") for (int k = 0; k < 2; ++k) dst[n][k] = *(const PG8_LAS bf16x8*)(lds + PG8_SB(b, h) + boff + n * 2048 + k * 1024); } while (0)
#define PG8_MMA(ai, bj, At, Bt) do { __builtin_amdgcn_s_setprio(1); _Pragma("unroll") for (int m = 0; m < 4; ++m) _Pragma("unroll") for (int n = 0; n < 2; ++n) _Pragma("unroll") for (int k = 0; k < 2; ++k) \
        acc[ai][bj][m][n] = __builtin_amdgcn_mfma_f32_16x16x32_bf16(Bt[n][k], At[m][k], acc[ai][bj][m][n], 0, 0, 0); __builtin_amdgcn_s_setprio(0); } while (0)
#define PG8_WAIT_V(n) asm volatile("s_waitcnt vmcnt(" #n ")" ::: "memory")
#define PG8_WAIT_L(n) asm volatile("s_waitcnt lgkmcnt(" #n ")" ::: "memory")
#define PG8_BAR __builtin_amdgcn_s_barrier()
#define PG8_SCHED __builtin_amdgcn_sched_barrier(0)
    Unit cur, nxt; int ui = 0;
    if (!S.next(0, cur)) return;
    f32x4 acc[2][2][4][2];
#pragma unroll
    for (int a = 0; a < 2; ++a)
#pragma unroll
        for (int b = 0; b < 2; ++b)
#pragma unroll
            for (int m = 0; m < 4; ++m)
#pragma unroll
                for (int n = 0; n < 2; ++n) acc[a][b][m][n] = (f32x4){0.f, 0.f, 0.f, 0.f};
    bf16x8 At[4][2], B0[2][2], B1[2][2];
    const char* cA = (const char*)g.A + (size_t)cur.pm * tstep; const char* cB = (const char*)g.Bt + (size_t)cur.pn * tstep;
    S.a_ready(cur);
    if constexpr (SP2) {
        PG8_STAGE(PG8_SB(0, 0), cB, voffB); PG8_STAGE(PG8_SB(0, 1), cB + hstep, voffB); PG8_STAGE(PG8_SA(0, 0), cA, voffA); PG8_STAGE(PG8_SA(0, 1), cA + hstep, voffA);
        if (wr == 1) PG8_BAR;
        PG8_WAIT_V(2); PG8_BAR;
        PG8_STAGE(PG8_SB(1, 0), cB + kstep, voffB); PG8_STAGE(PG8_SA(1, 0), cA + kstep, voffA); PG8_STAGE(PG8_SB(1, 1), cB + hstep + kstep, voffB);
        PG8_WAIT_V(6); PG8_BAR;
    } else {
        PG8_STAGE(PG8_SB(0, 0), cB, voffB); PG8_STAGE(PG8_SA(0, 0), cA, voffA); PG8_STAGE(PG8_SB(0, 1), cB + hstep, voffB); PG8_STAGE(PG8_SA(0, 1), cA + hstep, voffA);
        if (wr == 1) PG8_BAR;
        PG8_WAIT_V(4); PG8_BAR;
        PG8_STAGE(PG8_SB(1, 0), cB + kstep, voffB); PG8_STAGE(PG8_SA(1, 0), cA + kstep, voffA); PG8_STAGE(PG8_SB(1, 1), cB + hstep + kstep, voffB);
        PG8_WAIT_V(6); PG8_BAR;
    }
    for (;;) {
        const bool has_next = S.next(ui + 1, nxt);
        const char* nA = has_next ? (const char*)g.A + (size_t)nxt.pm * tstep : cA; const char* nB = has_next ? (const char*)g.Bt + (size_t)nxt.pn * tstep : cB;
        for (int t = 0; t < nt; t += 2) {
            const bool last = (t == nt - 2);
            const char* a1 = cA + (size_t)(t + 1) * kstep;
            const char* a2 = last ? nA : cA + (size_t)(t + 2) * kstep; const char* b2 = last ? nB : cB + (size_t)(t + 2) * kstep;
            const char* a3 = a2 + kstep; const char* b3 = b2 + kstep;
            if (last && has_next) S.a_ready(nxt);
            if constexpr (SP2) {
            PG8_LDB(B0, 0, 0); PG8_LDB(B1, 0, 1); PG8_SCHED; PG8_LDA(At, 0, 0); PG8_STAGE(PG8_SA(1, 1), a1 + hstep, voffA);
            PG8_WAIT_V(8); PG8_WAIT_L(0); PG8_BAR; PG8_MMA(0, 0, At, B0); PG8_MMA(0, 1, At, B1); PG8_BAR; PG8_SCHED;
            PG8_LDA(At, 0, 1); PG8_STAGE(PG8_SB(0, 0), b2, voffB); PG8_STAGE(PG8_SB(0, 1), b2 + hstep, voffB); PG8_STAGE(PG8_SA(0, 0), a2, voffA);
            PG8_WAIT_V(8); PG8_WAIT_L(0); PG8_BAR; PG8_MMA(1, 0, At, B0); PG8_MMA(1, 1, At, B1); PG8_BAR; PG8_SCHED;
            PG8_LDB(B0, 1, 0); PG8_LDB(B1, 1, 1); PG8_SCHED; PG8_LDA(At, 1, 0); PG8_STAGE(PG8_SA(0, 1), a2 + hstep, voffA);
            PG8_WAIT_V(8); PG8_WAIT_L(0); PG8_BAR; PG8_MMA(0, 0, At, B0); PG8_MMA(0, 1, At, B1); PG8_BAR; PG8_SCHED;
            PG8_LDA(At, 1, 1); PG8_STAGE(PG8_SB(1, 0), b3, voffB); PG8_STAGE(PG8_SB(1, 1), b3 + hstep, voffB); PG8_STAGE(PG8_SA(1, 0), a3, voffA);
            PG8_WAIT_V(8); PG8_WAIT_L(0); PG8_BAR; PG8_MMA(1, 0, At, B0); PG8_MMA(1, 1, At, B1); PG8_BAR; PG8_SCHED;
            } else {
            PG8_LDB(B0, 0, 0); PG8_SCHED; PG8_LDA(At, 0, 0); PG8_STAGE(PG8_SA(1, 1), a1 + hstep, voffA);
            PG8_WAIT_L(8); PG8_BAR; PG8_WAIT_L(0); PG8_MMA(0, 0, At, B0); PG8_BAR; PG8_SCHED;
            PG8_LDB(B1, 0, 1); PG8_STAGE(PG8_SB(0, 0), b2, voffB);
            PG8_BAR; PG8_WAIT_L(0); PG8_MMA(0, 1, At, B1); PG8_BAR;
            PG8_LDA(At, 0, 1); PG8_STAGE(PG8_SA(0, 0), a2, voffA);
            PG8_BAR; PG8_WAIT_L(0); PG8_MMA(1, 0, At, B0); PG8_BAR; PG8_SCHED;
            PG8_STAGE(PG8_SB(0, 1), b2 + hstep, voffB);
            PG8_WAIT_V(6); PG8_BAR; PG8_MMA(1, 1, At, B1); PG8_BAR;
            PG8_LDB(B0, 1, 0); PG8_SCHED; PG8_LDA(At, 1, 0); PG8_STAGE(PG8_SA(0, 1), a2 + hstep, voffA);
            PG8_WAIT_L(8); PG8_BAR; PG8_WAIT_L(0); PG8_MMA(0, 0, At, B0); PG8_BAR; PG8_SCHED;
            PG8_LDB(B1, 1, 1); PG8_STAGE(PG8_SB(1, 0), b3, voffB);
            PG8_BAR; PG8_WAIT_L(0); PG8_MMA(0, 1, At, B1); PG8_BAR;
            PG8_LDA(At, 1, 1); PG8_STAGE(PG8_SA(1, 0), a3, voffA);
            PG8_BAR; PG8_WAIT_L(0); PG8_MMA(1, 0, At, B0); PG8_BAR; PG8_SCHED;
            PG8_STAGE(PG8_SB(1, 1), b3 + hstep, voffB);
            PG8_WAIT_V(6); PG8_BAR; PG8_MMA(1, 1, At, B1); PG8_BAR;
            }
        }
        if constexpr (ALIGN_EPI) { if (wr == 0) PG8_BAR; }
        if constexpr (!Epi::AFTER_DRAIN) { E(acc, cur, wr, wc, fr, fq); S.done(cur); }
        if (!has_next) break;
#pragma unroll
        for (int a = 0; a < 2; ++a)
#pragma unroll
            for (int b = 0; b < 2; ++b)
#pragma unroll
                for (int m = 0; m < 4; ++m)
#pragma unroll
                    for (int n = 0; n < 2; ++n) acc[a][b][m][n] = (f32x4){0.f, 0.f, 0.f, 0.f};
        cur = nxt; cA = nA; cB = nB; ++ui;
        if constexpr (ALIGN_EPI) { if (wr == 1) PG8_BAR; }
    }
    PG8_WAIT_V(0);
    if constexpr (!ALIGN_EPI) { if (wr == 0) PG8_BAR; }
    PG8_BAR;
    if constexpr (Epi::AFTER_DRAIN) { E.fused(acc, cur, wr, wc, fr, fq, lds, wid, lane); S.done(cur); }
#undef PG8_SA
#undef PG8_SB
#undef PG8_STAGE
#undef PG8_LDA
#undef PG8_LDB
#undef PG8_MMA
#undef PG8_WAIT_V
#undef PG8_WAIT_L
#undef PG8_BAR
#undef PG8_SCHED
}
}

#ifndef PG8_SP2
#define PG8_SP2 true
#endif
#ifndef PG8_ALIGN
#define PG8_ALIGN true
#endif
#include <hip/hip_bf16.h>
namespace attn128 {
using bf16=__hip_bfloat16;
using bf16x8=__attribute__((ext_vector_type(8)))short;
using s16x4=__attribute__((ext_vector_type(4)))short;
using f32x16=__attribute__((ext_vector_type(16)))float;
using u32x4=__attribute__((ext_vector_type(4)))unsigned;
constexpr int SEQ=16384,PIN=6144,POUT=2048,QB=256,NQB=SEQ/QB;
constexpr int KBUF=8192,VBUF=16384;
constexpr int LDS_K=0,LDS_V=3*KBUF,LDS_OST=0,LDS_WS=65536,LDS_Q=LDS_WS+8*64*4,LDS_BYTES=LDS_Q+8*4096;
constexpr float C2=0.125f*1.4426950408889634f;
__device__ __forceinline__ int crow(int r,int hi){return (r&3)+8*(r>>2)+4*hi;}
__device__ __forceinline__ void glds16(const void*gsrc,unsigned lds_dst){unsigned keep;
  asm volatile("s_mov_b32 %0, m0\n\ts_mov_b32 m0, %2\n\ts_nop 0\n\tglobal_load_lds_dwordx4 %1, off\n\ts_mov_b32 m0, %0":"=&s"(keep):"v"(gsrc),"s"(lds_dst):"memory");}
__device__ __forceinline__ void glds16s(const void*sbase,unsigned voff,unsigned lds_dst){unsigned keep;
  asm volatile("s_mov_b32 %0, m0\n\ts_mov_b32 m0, %3\n\ts_nop 0\n\tglobal_load_lds_dwordx4 %1, %2\n\ts_mov_b32 m0, %0":"=&s"(keep):"v"(voff),"s"(sbase),"s"(lds_dst):"memory");}
typedef float f32x2_t __attribute__((ext_vector_type(2))); typedef __bf16 bf16x2_t __attribute__((ext_vector_type(2)));
__device__ __forceinline__ unsigned cvtpk_s(float lo,float hi){f32x2_t v={lo,hi};bf16x2_t b=__builtin_convertvector(v,bf16x2_t);return __builtin_bit_cast(unsigned,b);}
__device__ __forceinline__ float max3f(float a,float b,float c){float r;asm("v_max3_f32 %0, %1, %2, %3":"=v"(r):"v"(a),"v"(b),"v"(c));return r;}
__device__ __forceinline__ float max2f(float a,float b){float r;asm("v_max_f32_e32 %0, %1, %2":"=v"(r):"v"(a),"v"(b));return r;}
typedef __attribute__((address_space(3))) const char* lds_cptr;
typedef short v4i16_t __attribute__((ext_vector_type(4)));
__device__ __forceinline__ s16x4 vtr(lds_cptr p){ return __builtin_bit_cast(s16x4,__builtin_amdgcn_ds_read_tr16_b64_v4i16((__attribute__((address_space(3))) v4i16_t*)p)); }
#define A128_WAITBAR() asm volatile("s_waitcnt vmcnt(0) lgkmcnt(0)\n\ts_barrier":::"memory")
#define SB() __builtin_amdgcn_sched_barrier(0)
#define LDSQ(p) (*(const __attribute__((address_space(3))) bf16x8*)(p))
#define MF32(a,b,c) __builtin_amdgcn_mfma_f32_32x32x16_bf16(a,b,c,0,0,0)
#define EXP1(x) x=__builtin_amdgcn_exp2f((x)-mh_)
struct St { float mhat,l_reg; f32x16 o[4]; };
template<bool GUARD> __device__ __forceinline__ float rowmax32(f32x16&p0,f32x16&p1){
  if(GUARD) asm volatile("s_nop 15\n\ts_nop 7":"+v"(p0),"+v"(p1));
  float a=max3f(p0[0],p0[1],p1[0]),b=max3f(p0[2],p0[3],p1[1]);a=max3f(a,p1[2],p1[3]);
  #pragma unroll
  for(int r=4;r<16;r+=4){a=max3f(a,p0[r],p0[r+1]);b=max3f(b,p0[r+2],p0[r+3]);a=max3f(a,p1[r],p1[r+1]);b=max3f(b,p1[r+2],p1[r+3]);}
  const float m=max2f(a,b); auto rr=__builtin_amdgcn_permlane32_swap(__float_as_uint(m),__float_as_uint(m),false,false);
  return max2f(__uint_as_float(rr[0]),__uint_as_float(rr[1]));
}
template<int THRL,bool FIRST> __device__ __forceinline__ void decide(float rm,St&S,float*wsf,int r32,int hi){
  if(FIRST){ S.mhat=rm; }
  else if(__any(rm-S.mhat>(float)THRL)){
    const float dl=__builtin_fmaxf(rm-S.mhat,0.f); S.mhat+=dl;
    const float f=__builtin_amdgcn_exp2f(-dl); S.l_reg*=f; if(hi==0)wsf[r32]=f;
    asm volatile("s_waitcnt lgkmcnt(0)":::"memory");
    #pragma unroll
    for(int r=0;r<16;++r){ const float fr=wsf[crow(r,hi)];
      #pragma unroll
      for(int d=0;d<4;++d)S.o[d][r]*=fr; }
  }
}
template<int THRL,bool FIRST> __device__ __forceinline__ void softmax_head(f32x16&p0,f32x16&p1,St&S,float*wsf,int r32,int hi){ decide<THRL,FIRST>(rowmax32<true>(p0,p1),S,wsf,r32,hi); }
__device__ __forceinline__ bf16x8 vfrag(lds_cptr vp,int i){ const s16x4 lo=vtr(vp+(i&3)*4096+(i>>2)*1024), hh=vtr(vp+(i&3)*4096+(i>>2)*1024+512); return (bf16x8){lo[0],lo[1],lo[2],lo[3],hh[0],hh[1],hh[2],hh[3]}; }
__device__ __forceinline__ u32x4 packw(const f32x16&p,int base){ u32x4 w; w[0]=cvtpk_s(p[base],p[base+1]); w[1]=cvtpk_s(p[base+2],p[base+3]); w[2]=cvtpk_s(p[base+4],p[base+5]); w[3]=cvtpk_s(p[base+6],p[base+7]); return w; }
__device__ __forceinline__ void qk_plain(f32x16&n0,f32x16&n1,lds_cptr kp,lds_cptr qp){
  bf16x8 qa=LDSQ(qp),qb=LDSQ(qp+1024); const f32x16 z=f32x16{};
  n0=MF32(LDSQ(kp),qa,z); n1=MF32(LDSQ(kp+512),qa,z); qa=LDSQ(qp+2048);
  n0=MF32(LDSQ(kp+2048),qb,n0); n1=MF32(LDSQ(kp+2560),qb,n1); qb=LDSQ(qp+3072);
  n0=MF32(LDSQ(kp+4096),qa,n0); n1=MF32(LDSQ(kp+4608),qa,n1);
  n0=MF32(LDSQ(kp+6144),qb,n0); n1=MF32(LDSQ(kp+6656),qb,n1);
}
__device__ __forceinline__ void expsum_pv_plain(f32x16&p0,f32x16&p1,St&S,lds_cptr vp){
  float s=0.f; const float mh_=S.mhat;
  #pragma unroll
  for(int r=0;r<16;++r){EXP1(p0[r]);EXP1(p1[r]);s+=p0[r]+p1[r];}
  S.l_reg+=s;
  u32x4 pw[4]; pw[0]=packw(p0,0); pw[1]=packw(p0,8); pw[2]=packw(p1,0); pw[3]=packw(p1,8);
  #pragma unroll
  for(int i=0;i<16;++i){ const bf16x8 vf=vfrag(vp,i); S.o[i&3]=MF32(__builtin_bit_cast(bf16x8,pw[i>>2]),vf,S.o[i&3]); }
}
template<int THRL,bool FIRST> __device__ __forceinline__ void step_main(f32x16&p0,f32x16&p1,f32x16&n0,f32x16&n1,St&S,lds_cptr kpn,lds_cptr qp,lds_cptr vp,float*wsf,int r32,int hi,float&rm){
  #define KF(i) LDSQ(kpn+((i)>>1)*2048+((i)&1)*512)
  #define QF(d0) LDSQ(qp+(d0)*1024)
  bf16x8 ka=KF(0),kb=KF(1),kc=KF(2),kd=KF(3),qa=QF(0),qb=QF(1);
  decide<THRL,FIRST>(rm,S,wsf,r32,hi);
  u32x4 pw0,pw1,pw2,pw3; const float mh_=S.mhat; const f32x16 z=f32x16{};
  SB();
  n0=MF32(ka,qa,z); ka=KF(4); EXP1(p0[0]);EXP1(p0[1]);EXP1(p0[2]); SB();
  n1=MF32(kb,qa,z); kb=KF(5); qa=QF(2); EXP1(p0[3]);EXP1(p0[4]);EXP1(p0[5]); SB();
  n0=MF32(kc,qb,n0);   kc=KF(6); EXP1(p0[6]);EXP1(p0[7]);EXP1(p0[8]); SB();
  n1=MF32(kd,qb,n1);   kd=KF(7); qb=QF(3); EXP1(p0[9]);EXP1(p0[10]);EXP1(p0[11]); SB();
  bf16x8 vfa=vfrag(vp,0);
  n0=MF32(ka,qa,n0);   EXP1(p0[12]);EXP1(p0[13]);EXP1(p0[14]); pw0=packw(p0,0); SB();
  bf16x8 vfb=vfrag(vp,1);
  n1=MF32(kb,qa,n1);   EXP1(p0[15]);EXP1(p1[0]);EXP1(p1[1]); SB();
  bf16x8 vfc=vfrag(vp,2);
  n0=MF32(kc,qb,n0);   EXP1(p1[2]);EXP1(p1[3]);EXP1(p1[4]); pw1=packw(p0,8); SB();
  bf16x8 vfd=vfrag(vp,3);
  n1=MF32(kd,qb,n1);   EXP1(p1[5]);EXP1(p1[6]);EXP1(p1[7]); SB();
  #undef KF
  #undef QF
  float sa=p0[0]+p0[1];
  #define PVG(i,PW,VF,NEXTI,X0,X1,Y0,Y1,EXTRA) do{ S.o[(i)&3]=MF32(__builtin_bit_cast(bf16x8,PW),VF,S.o[(i)&3]); if((NEXTI)<16){ VF=vfrag(vp,(NEXTI)<16?(NEXTI):0); } sa+=X0; sa+=X1; sa+=Y0; sa+=Y1; EXTRA; SB(); }while(0)
  PVG(0,pw0,vfa,4, p0[2],p0[3],p0[4],p0[5],   do{EXP1(p1[8]);EXP1(p1[9]);}while(0));
  PVG(1,pw0,vfb,5, p0[6],p0[7],p0[8],p0[9], do{EXP1(p1[10]);EXP1(p1[11]);}while(0));
  PVG(2,pw0,vfc,6, p0[10],p0[11],p0[12],p0[13], do{EXP1(p1[12]);EXP1(p1[13]);}while(0));
  PVG(3,pw0,vfd,7, p0[14],p0[15],p1[0],p1[1],   do{EXP1(p1[14]);EXP1(p1[15]);}while(0));
  PVG(4,pw1,vfa,8, p1[2],p1[3],p1[4],p1[5],   pw2=packw(p1,0));
  PVG(5,pw1,vfb,9, p1[6],p1[7],p1[8],p1[9], pw3=packw(p1,8));
  PVG(6,pw1,vfc,10, p1[10],p1[11],p1[12],p1[13], do{}while(0));
  PVG(7,pw1,vfd,11, p1[14],p1[15],0.f,0.f, do{}while(0));
  float ma,mb;
  #define PINAB() asm volatile("":"+v"(ma),"+v"(mb))
  PVG(8,pw2,vfa,12,0.f,0.f,0.f,0.f, do{ma=max3f(n0[0],n0[1],n1[0]);mb=max3f(n0[2],n0[3],n1[1]);PINAB();}while(0));
  PVG(9,pw2,vfb,13,0.f,0.f,0.f,0.f, do{ma=max3f(ma,n1[2],n1[3]);mb=max3f(mb,n0[4],n0[5]);PINAB();}while(0));
  PVG(10,pw2,vfc,14,0.f,0.f,0.f,0.f, do{ma=max3f(ma,n0[6],n0[7]);mb=max3f(mb,n1[4],n1[5]);PINAB();}while(0));
  PVG(11,pw2,vfd,15,0.f,0.f,0.f,0.f, do{ma=max3f(ma,n1[6],n1[7]);mb=max3f(mb,n0[8],n0[9]);PINAB();}while(0));
  PVG(12,pw3,vfa,16,0.f,0.f,0.f,0.f, do{ma=max3f(ma,n0[10],n0[11]);mb=max3f(mb,n1[8],n1[9]);PINAB();}while(0));
  PVG(13,pw3,vfb,16,0.f,0.f,0.f,0.f, do{ma=max3f(ma,n1[10],n1[11]);mb=max3f(mb,n0[12],n0[13]);PINAB();}while(0));
  PVG(14,pw3,vfc,16,0.f,0.f,0.f,0.f, do{ma=max3f(ma,n0[14],n0[15]);mb=max3f(mb,n1[12],n1[13]);PINAB();}while(0));
  PVG(15,pw3,vfd,16,0.f,0.f,0.f,0.f, do{ma=max3f(ma,n1[14],n1[15]);ma=max2f(ma,mb);PINAB();}while(0));
  #undef PINAB
  { auto rr=__builtin_amdgcn_permlane32_swap(__float_as_uint(ma),__float_as_uint(ma),false,false); rm=max2f(__uint_as_float(rr[0]),__uint_as_float(rr[1])); }
  #undef PVG
  S.l_reg+=sa;
}
template<int THRL> __device__ __forceinline__ void unit(int qb,const bf16*Q,const bf16*K,const bf16*V,bf16*O,char*shm){
  int tid_=threadIdx.x; asm volatile("":"+v"(tid_));
  const int tid=tid_,lane=tid&63,r32=lane&31,hi=lane>>5; const int wid=__builtin_amdgcn_readfirstlane(tid>>6);
  const int q0=qb*QB;
  const bf16*Qw=Q+(long)(q0+wid*32)*PIN;
  const unsigned lds0=(unsigned)(uintptr_t)shm;
  float*wsf=(float*)(shm+LDS_WS)+wid*64;
  const unsigned koff=(unsigned)(lane*PIN+wid*8)*2u;
  const unsigned voff=(unsigned)((16*(wid&3)+(lane>>2))*PIN+(wid>>2)*32+(lane&3)*8)*2u;
  const unsigned kdst=lds0+LDS_K+wid*1024, vdst=lds0+LDS_V+wid*1024;
  #define DMA_K(t,so) glds16s((const char*)K+(size_t)(t)*(64*PIN*2),koff,(unsigned)__builtin_amdgcn_readfirstlane(kdst+(so)))
  #define DMA_V(t,so) do{ glds16s((const char*)V+(size_t)(t)*(64*PIN*2),voff,(unsigned)__builtin_amdgcn_readfirstlane(vdst+(so))); glds16s((const char*)V+(size_t)(t)*(64*PIN*2)+128,voff,(unsigned)__builtin_amdgcn_readfirstlane(vdst+(so)+8192)); }while(0)
  const lds_cptr shm3=(lds_cptr)shm; const lds_cptr kp0=shm3+LDS_K+hi*1024+r32*16; const lds_cptr vp0=shm3+LDS_V+((lane>>4)&1)*32+(lane&3)*8+(4*hi+((lane&15)>>2))*64;
  const lds_cptr qp=shm3+LDS_Q+wid*4096+hi*512+r32*16;
  const int NT=(q0+QB)/64, g=wid>>1;
  DMA_K(0,0); DMA_V(0,0); DMA_K(1,KBUF);
  { bf16x8 qt[4];
    #pragma unroll
    for(int d0=0;d0<4;++d0)qt[d0]=*reinterpret_cast<const bf16x8*>(&Qw[(long)r32*PIN+d0*16+hi*8]);
    #pragma unroll
    for(int d0=0;d0<4;++d0)*(__attribute__((address_space(3))) bf16x8*)(shm3+LDS_Q+wid*4096+hi*512+r32*16+d0*1024)=qt[d0]; }
  St S; S.mhat=0.f; S.l_reg=0.f;
  #pragma unroll
  for(int d=0;d<4;++d)S.o[d]=f32x16{};
  A128_WAITBAR();
  f32x16 pA0,pA1,pB0,pB1;
  qk_plain(pA0,pA1,kp0,qp);
  float rm=0.f;
  int ks1=KBUF, ks2=2*KBUF;
  #define ROT() do{ ks1=ks2; ks2=(ks2==2*KBUF)?0:ks2+KBUF; }while(0)
  int t=0;
  if(NT>4){
    rm=rowmax32<true>(pA0,pA1);
    DMA_K(2,ks2); DMA_V(1,VBUF);
    step_main<THRL,true>(pA0,pA1,pB0,pB1,S,kp0+ks1,qp,vp0,wsf,r32,hi,rm); A128_WAITBAR(); ROT();
    DMA_K(3,ks2); DMA_V(2,0);
    step_main<THRL,false>(pB0,pB1,pA0,pA1,S,kp0+ks1,qp,vp0+VBUF,wsf,r32,hi,rm); A128_WAITBAR(); ROT();
    for(t=2;t<NT-4;t+=2){
      DMA_K(t+2,ks2); DMA_V(t+1,VBUF);
      step_main<THRL,false>(pA0,pA1,pB0,pB1,S,kp0+ks1,qp,vp0,wsf,r32,hi,rm); A128_WAITBAR(); ROT();
      DMA_K(t+3,ks2); DMA_V(t+2,0);
      step_main<THRL,false>(pB0,pB1,pA0,pA1,S,kp0+ks1,qp,vp0+VBUF,wsf,r32,hi,rm); A128_WAITBAR(); ROT();
    }
  }
  #define BAND(jb,P0,P1,N0,N1,VOFF) do{ const int tt=NT-4+(jb); \
      if((jb)+2<4) DMA_K(tt+2,ks2); if((jb)+1<4) DMA_V(tt+1,(VOFF)^VBUF); \
      if((jb)<=g){ if(tt==0) softmax_head<THRL,true>(P0,P1,S,wsf,r32,hi); else softmax_head<THRL,false>(P0,P1,S,wsf,r32,hi); } \
      if((jb)+1<4&&(jb)+1<=g) qk_plain(N0,N1,kp0+ks1,qp); \
      if((jb)<=g) expsum_pv_plain(P0,P1,S,vp0+(VOFF)); \
      A128_WAITBAR(); ROT(); }while(0)
  BAND(0,pA0,pA1,pB0,pB1,0);
  BAND(1,pB0,pB1,pA0,pA1,VBUF);
  BAND(2,pA0,pA1,pB0,pB1,0);
  BAND(3,pB0,pB1,pA0,pA1,VBUF);
  #undef BAND
  #undef ROT
  float l_reg=S.l_reg;
  {auto rr=__builtin_amdgcn_permlane32_swap(__float_as_uint(l_reg),__float_as_uint(l_reg),false,false);l_reg=__uint_as_float(rr[0])+__uint_as_float(rr[1]);}
  if(hi==0)wsf[32+r32]=l_reg; asm volatile("s_waitcnt lgkmcnt(0)":::"memory");
  bf16*Ow=O+(long)(q0+wid*32)*POUT;
  { bf16*stg=(bf16*)(shm+LDS_OST)+wid*4096;
    #pragma unroll
    for(int r=0;r<16;++r){ const int orow=crow(r,hi); const float rl=__builtin_amdgcn_rcpf(wsf[32+orow]);
      #pragma unroll
      for(int d=0;d<4;++d)stg[orow*128+d*32+r32]=__float2bfloat16(S.o[d][r]*rl); }
    asm volatile("s_waitcnt lgkmcnt(0)":::"memory");
    #pragma unroll
    for(int i=0;i<8;++i){ const int row=i*4+(lane>>4),ch=lane&15; const u32x4 v=*(const u32x4*)(stg+row*128+ch*8); *(u32x4*)(Ow+(long)row*POUT+ch*8)=v; } }
  asm volatile("s_waitcnt lgkmcnt(0)\n\ts_barrier":::"memory");
  #undef DMA_K
  #undef DMA_V
}
struct AttnTensors { const bf16* QKV; bf16* O; };
template<int THRL=8> __device__ __forceinline__ void attn_phase(char*lds,const AttnTensors&T,int grid,int block){
  for(int v0=block;v0<256;v0+=grid){
    const int vcu=(v0%8)*32+v0/8, hc=vcu>>4, s=vcu&15, h=hc>>1;
    const bf16*Q=T.QKV+3072+hc*64,*K=T.QKV+4096+hc*64,*V=T.QKV+5120+h*128; bf16*O=T.O+hc*128;
    for(int i=3;i>=0;--i){ const int qb=(i&1)?(32*(i>>1)+31-s):(32*(i>>1)+s); unit<THRL>(qb,Q,K,V,O,lds); }
  }
}
#undef A128_WAITBAR
}
constexpr int M = 16384, DM = 2048, NPROJ = 6144, FF = 5632, NGU = 2 * FF;
constexpr int MH = 4, DQK = 128, DV = 256, CH = 64, NCH = M / CH;
constexpr float EPS = 1e-6f;
constexpr float LAM_INIT = 0.2f;
constexpr int PC_MV = 1024, PC_MO = 2048, PC_AQ = 3072;
constexpr size_t MiB = 1u << 20;
constexpr size_t WS_GATES = 0;
constexpr size_t WS_LOGF = 512 * 1024;
constexpr size_t WS_IG = 768 * 1024;
constexpr size_t WS_GDEC = 1024 * 1024;
constexpr size_t WS_UN = 1536 * 1024;
constexpr size_t WS_NST = 2048 * 1024;
constexpr size_t WS_BAR = 3072 * 1024;
constexpr size_t WS_WIN = 4 * MiB;
constexpr size_t WS_QKM = 4 * MiB;
constexpr size_t WS_WOUT = 36 * MiB;
constexpr size_t WS_WGU = 44 * MiB;
constexpr size_t WS_WD = 88 * MiB;
constexpr size_t WS_XN = 110 * MiB;
constexpr size_t WS_ATTO = 110 * MiB;
constexpr size_t WS_PROJ = 174 * MiB;
constexpr size_t WS_ACT = 174 * MiB;
constexpr size_t WS_CT = 366 * MiB;
constexpr size_t WS_CAT = 430 * MiB;
constexpr size_t WS_TAB = 494 * MiB;
constexpr size_t WS_END = 498 * MiB;

constexpr int LDS_BYTES = 147456;
#define LAS __attribute__((address_space(3)))
typedef unsigned short bf16;
typedef float f32x4 __attribute__((ext_vector_type(4)));
typedef unsigned u32x4 __attribute__((ext_vector_type(4)));
typedef unsigned u32x2 __attribute__((ext_vector_type(2)));
typedef short bf16x8 __attribute__((ext_vector_type(8)));
#define LDS_WAIT() asm volatile("s_waitcnt lgkmcnt(0)" ::: "memory")

__device__ __forceinline__ float bf2f(unsigned h) { return __uint_as_float(h << 16); }
__device__ __forceinline__ unsigned pk2(float lo, float hi) { return pg8::cvt_pk_bf16(lo, hi); }
__device__ __forceinline__ float wave_sum(float v) {
#pragma unroll
    for (int o = 1; o < 64; o <<= 1) v += __shfl_xor(v, o);
    return v;
}
__device__ __forceinline__ float sigmoidf_(float v) { return 1.0f / (1.0f + __expf(-v)); }

struct Args {
    const float* in[19]; float* out; unsigned char* ws; float inv[32]; int ph_lo, ph_hi;
};
struct Ctx { LAS unsigned char* lds; int tid, lane, wave, G, bid; unsigned char* ws; };

__device__ __forceinline__ void p0_transpose_item(const float* W, int K, int Nsrc, int src_col0, bf16* WT, int dst_row0, int kb, LAS float* scr, int lane, bool perm = false) {
    const int k0 = 64 * kb, c4 = lane & 15, kr = lane >> 4;
    f32x4 v[16];
#pragma unroll
    for (int i = 0; i < 16; ++i) v[i] = *(const f32x4*)(W + (size_t)(k0 + 4 * i + kr) * Nsrc + src_col0 + 4 * c4);
#pragma unroll
    for (int i = 0; i < 16; ++i) { LAS float* d = scr + (4 * i + kr) * 65 + 4 * c4; d[0] = v[i].x; d[1] = v[i].y; d[2] = v[i].z; d[3] = v[i].w; }
    LDS_WAIT(); asm volatile("" ::: "memory");
    const int c = lane & 7;
#pragma unroll
    for (int j = 0; j < 8; ++j) { const int n = (lane >> 3) + 8 * j, sc = perm ? ((n >> 1) + 32 * (n & 1)) : n; const LAS float* p = scr + (8 * c) * 65 + sc;
        u32x4 o; o.x = pk2(p[0 * 65], p[1 * 65]); o.y = pk2(p[2 * 65], p[3 * 65]); o.z = pk2(p[4 * 65], p[5 * 65]); o.w = pk2(p[6 * 65], p[7 * 65]);
        *(u32x4*)(WT + (size_t)(dst_row0 + n) * K + k0 + 8 * c) = o; }
    LDS_WAIT(); asm volatile("" ::: "memory");
}
template <int PART  > __device__ __forceinline__ void p0_weights(const Ctx& C, const float* w_in, const float* w_out, const float* w_gate, const float* w_up, const float* w_down) {
    LAS float* scr = (LAS float*)(C.lds + C.wave * 16640);
    const int gw = C.bid * 8 + C.wave, NGW = C.G * 8;
    constexpr int I_IN = 32 * 96, I_OUT = 32 * 32, I_G = 32 * 88, I_D = 88 * 32;
    constexpr int NITEMS = I_IN + I_OUT + 2 * I_G + I_D;
    bf16* WinT = (bf16*)(C.ws + WS_WIN); bf16* WoutT = (bf16*)(C.ws + WS_WOUT); bf16* WguT = (bf16*)(C.ws + WS_WGU); bf16* WdT = (bf16*)(C.ws + WS_WD);
    constexpr int IT_LO = PART == 0 ? 0 : PART == 1 ? I_IN : PART == 2 ? I_IN + I_OUT : I_IN + I_OUT + 2 * I_G, IT_HI = PART == 0 ? I_IN : PART == 1 ? I_IN + I_OUT : PART == 2 ? I_IN + I_OUT + 2 * I_G : NITEMS;
    for (int it = IT_LO + gw; it < IT_HI; it += NGW) {
        int r = it;
        if (r < I_IN) { const int kb = r / 96, nb = r % 96, n0 = 64 * nb; const bool rp = (n0 >= 3072 && n0 < 5120);
            p0_transpose_item(w_in, DM, 6152, n0 + (n0 >= 3072 ? 8 : 0), WinT, n0, kb, scr, C.lane, rp); continue; } r -= I_IN;
        if (r < I_OUT) { const int kb = r / 32, nb = r % 32; p0_transpose_item(w_out, DM, DM, 64 * nb, WoutT, 64 * nb, kb, scr, C.lane); continue; } r -= I_OUT;
        if (r < I_G) { const int kb = r / 88, nb = r % 88, n0 = 64 * nb; p0_transpose_item(w_gate, DM, FF, n0, WguT, (n0 >> 7) * 256 + (n0 & 127), kb, scr, C.lane); continue; } r -= I_G;
        if (r < I_G) { const int kb = r / 88, nb = r % 88, n0 = 64 * nb; p0_transpose_item(w_up, DM, FF, n0, WguT, (n0 >> 7) * 256 + 128 + (n0 & 127), kb, scr, C.lane); continue; } r -= I_G;
        { const int kb = r / 32, nb = r % 32; p0_transpose_item(w_down, FF, DM, 64 * nb, WdT, 64 * nb, kb, scr, C.lane); }
    }
}
template <int MODE> __device__ __forceinline__ void rows_pass(const Ctx& C, const float* src, const float* g, bf16* dst_bf, float* dst_f, const LAS float* wg, const float* b_ig = nullptr, const float* b_fg = nullptr, const bf16* add_bf = nullptr, const bf16* add2_bf = nullptr) {
    const int gw = C.bid * 8 + C.wave, NGW = C.G * 8, lane = C.lane;
    for (int m = gw; m < M; m += NGW) {
        const f32x4* xr = (const f32x4*)(src + (size_t)m * DM) + lane;
        f32x4 v[8]; float ss = 0.f;
#pragma unroll
        for (int j = 0; j < 8; ++j) v[j] = xr[64 * j];
        if (MODE != 0) { const u32x2* ar = (const u32x2*)(add_bf + (size_t)m * DM) + lane;
#pragma unroll
            for (int j = 0; j < 8; ++j) { const u32x2 a = ar[64 * j]; v[j].x += bf2f(a.x & 0xffffu); v[j].y += bf2f(a.x >> 16); v[j].z += bf2f(a.y & 0xffffu); v[j].w += bf2f(a.y >> 16); }
            if (MODE == 2) { const u32x2* ar2 = (const u32x2*)(add2_bf + (size_t)m * DM) + lane;
#pragma unroll
                for (int j = 0; j < 8; ++j) { const u32x2 a = ar2[64 * j]; v[j].x += bf2f(a.x & 0xffffu); v[j].y += bf2f(a.x >> 16); v[j].z += bf2f(a.y & 0xffffu); v[j].w += bf2f(a.y >> 16); } } }
#pragma unroll
        for (int j = 0; j < 8; ++j) ss += (v[j].x * v[j].x + v[j].y * v[j].y) + (v[j].z * v[j].z + v[j].w * v[j].w);
        const float rs = 1.0f / sqrtf(wave_sum(ss) * (1.0f / DM) + EPS);
#pragma unroll
        for (int j = 0; j < 8; ++j) { const f32x4 gg = ((const f32x4*)g)[64 * j + lane]; v[j] = v[j] * rs * gg; }
        if (MODE == 2) {
            f32x4* o = (f32x4*)(dst_f + (size_t)m * DM) + lane;
#pragma unroll
            for (int j = 0; j < 8; ++j) o[64 * j] = v[j];
        } else {
            u32x2* o = (u32x2*)(dst_bf + (size_t)m * DM) + lane;
#pragma unroll
            for (int j = 0; j < 8; ++j) { u32x2 w; w.x = pk2(v[j].x, v[j].y); w.y = pk2(v[j].z, v[j].w); o[64 * j] = w; }
        }
        if (MODE == 0) {
            float ga[8];
#pragma unroll
            for (int q = 0; q < 8; ++q) { float a = 0.f;
#pragma unroll
                for (int j = 0; j < 8; ++j) { const f32x4 w = ((const LAS f32x4*)(wg + q * DM))[64 * j + lane]; a += (v[j].x * w.x + v[j].y * w.y) + (v[j].z * w.z + v[j].w * w.w); }
                ga[q] = wave_sum(a); }
            float mine = ga[0];
#pragma unroll
            for (int q = 1; q < 8; ++q) mine = (lane == q) ? ga[q] : mine;
            if (lane < 8) { const int hh = lane & 3; const float pre = mine + (lane < 4 ? b_ig[hh] : b_fg[hh]); const float cp = 15.0f * tanhf(pre * (1.0f / 15.0f));
                if (lane < 4) ((float*)(C.ws + WS_IG))[hh * M + m] = cp; else ((float*)(C.ws + WS_LOGF))[hh * M + m] = fminf(cp, 0.f) - log1pf(expf(-fabsf(cp))); }
        }
    }
}

namespace ml {
constexpr int VTS = 72, QKS = 136;
__device__ __forceinline__ float incl_scan64(float v, int lane) {
#pragma unroll
    for (int off = 1; off < 64; off <<= 1) { const float n = __shfl_up(v, off); if (lane >= off) v += n; }
    return v;
}
template <int NR> __device__ __forceinline__ void conv_rows(const bf16* PROJ, const float* conv_w, const float* conv_b, int chb, int trow0, float scale, float (&y)[NR][8]) {
    u32x4 xr[NR + 3];
#pragma unroll
    for (int k = 0; k < NR + 3; ++k) { const int t = trow0 - 3 + k; xr[k] = (t >= 0) ? *(const u32x4*)(PROJ + (size_t)t * NPROJ + chb) : (u32x4){0u, 0u, 0u, 0u}; }
    float cw[4][8], cb[8];
#pragma unroll
    for (int j = 0; j < 4; ++j) { const f32x4 a = *(const f32x4*)(conv_w + j * 1024 + chb), b = *(const f32x4*)(conv_w + j * 1024 + chb + 4);
        cw[j][0] = a.x; cw[j][1] = a.y; cw[j][2] = a.z; cw[j][3] = a.w; cw[j][4] = b.x; cw[j][5] = b.y; cw[j][6] = b.z; cw[j][7] = b.w; }
    { const f32x4 a = *(const f32x4*)(conv_b + chb), b = *(const f32x4*)(conv_b + chb + 4); cb[0] = a.x; cb[1] = a.y; cb[2] = a.z; cb[3] = a.w; cb[4] = b.x; cb[5] = b.y; cb[6] = b.z; cb[7] = b.w; }
#pragma unroll
    for (int r = 0; r < NR; ++r)
#pragma unroll
        for (int c = 0; c < 8; ++c) { float a = cb[c];
#pragma unroll
            for (int j = 0; j < 4; ++j) { const unsigned w = xr[r + j][c >> 1]; a += cw[j][c] * ((c & 1) ? bf2f(w >> 16) : bf2f(w & 0xffffu)); }
            y[r][c] = a * sigmoidf_(a) * scale; }
}
__device__ __forceinline__ void stage_vt(LAS bf16* VT, const bf16* PROJ, int row0, int col0, int wave, int lane) {
#pragma unroll
    for (int i = 0; i < 4; ++i) { const int ec = wave + 8 * i;
        const u32x4 v = *(const u32x4*)(PROJ + (size_t)(row0 + lane) * NPROJ + col0 + 8 * ec);
        LAS bf16* d = VT + (8 * ec) * VTS + lane;
        d[0 * VTS] = (bf16)(v.x & 0xffffu); d[1 * VTS] = (bf16)(v.x >> 16); d[2 * VTS] = (bf16)(v.y & 0xffffu); d[3 * VTS] = (bf16)(v.y >> 16);
        d[4 * VTS] = (bf16)(v.z & 0xffffu); d[5 * VTS] = (bf16)(v.z >> 16); d[6 * VTS] = (bf16)(v.w & 0xffffu); d[7 * VTS] = (bf16)(v.w >> 16); }
}
__device__ __forceinline__ void m1_phase(const Ctx& C, float* U, const float* conv_w, const float* conv_b) {
    const bf16* PROJ = (const bf16*)(C.ws + WS_PROJ);
    const float* LOGF = (const float*)(C.ws + WS_LOGF); const float* IG = (const float*)(C.ws + WS_IG);
    float* GDEC = (float*)(C.ws + WS_GDEC); float* UN = (float*)(C.ws + WS_UN);
    LAS bf16* VT = (LAS bf16*)C.lds; LAS bf16* KwT = (LAS bf16*)(C.lds + 36864); LAS float* wv = (LAS float*)(C.lds + 55296);
    const int lane = C.lane, wave = C.wave, fr = lane & 15, fq = lane >> 4;
    for (int unit = C.bid; unit < MH * NCH; unit += C.G) {
        const int h = unit >> 8, c = unit & 255, row0 = c * CH;
        if (wave == 0) { const float lf = LOGF[h * M + row0 + lane], ig = IG[h * M + row0 + lane]; const float b = incl_scan64(lf, lane); const float bl = __shfl(b, 63);
            wv[lane] = __expf(bl - b + ig); if (lane == 63) GDEC[unit] = __expf(bl); }
        const int cg = C.tid & 15, rgrp = C.tid >> 4; float y[2][8];
        conv_rows<2>(PROJ, conv_w, conv_b, 512 + h * DQK + 8 * cg, row0 + 2 * rgrp, 1.0f, y);
        stage_vt(VT, PROJ, row0, PC_MV + h * DV, wave, lane);
        __syncthreads();
        {
#pragma unroll
          for (int r = 0; r < 2; ++r) { const int sidx = 2 * rgrp + r; const float w = wv[sidx];
#pragma unroll
            for (int c = 0; c < 8; ++c) KwT[(8 * cg + c) * VTS + sidx] = (bf16)(pk2(y[r][c] * w, 0.f) & 0xffffu); } }
        __syncthreads();
        if (C.tid < DQK) { float s = 0.f;
#pragma unroll
            for (int j = 0; j < 64; ++j) s += bf2f(KwT[C.tid * VTS + j]);
            UN[unit * DQK + C.tid] = s; }
        f32x4 acc[2][8];
#pragma unroll
        for (int i = 0; i < 2; ++i)
#pragma unroll
            for (int dt = 0; dt < 8; ++dt) acc[i][dt] = (f32x4){0.f, 0.f, 0.f, 0.f};
        bf16x8 a[2][2];
#pragma unroll
        for (int i = 0; i < 2; ++i)
#pragma unroll
            for (int ks = 0; ks < 2; ++ks) a[i][ks] = *(const LAS bf16x8*)(VT + ((2 * wave + i) * 16 + fr) * VTS + 32 * ks + 8 * fq);
#pragma unroll
        for (int dt = 0; dt < 8; ++dt)
#pragma unroll
            for (int ks = 0; ks < 2; ++ks) { const bf16x8 b = *(const LAS bf16x8*)(KwT + (dt * 16 + fr) * VTS + 32 * ks + 8 * fq);
#pragma unroll
                for (int i = 0; i < 2; ++i) acc[i][dt] = __builtin_amdgcn_mfma_f32_16x16x32_bf16(a[i][ks], b, acc[i][dt], 0, 0, 0); }
        float* Uu = U + (size_t)unit * (DV * DQK);
#pragma unroll
        for (int i = 0; i < 2; ++i)
#pragma unroll
            for (int dt = 0; dt < 8; ++dt)
#pragma unroll
                for (int j = 0; j < 4; ++j) Uu[((2 * wave + i) * 16 + 4 * fq + j) * DQK + dt * 16 + fr] = acc[i][dt][j];
        __syncthreads();
    }
}
__device__ __forceinline__ void m2_scan(const Ctx& C, const float* U) {
    const float* GDEC = (const float*)(C.ws + WS_GDEC); const float* UN = (const float*)(C.ws + WS_UN); float* NST = (float*)(C.ws + WS_NST);
    bf16* CT = (bf16*)(C.ws + WS_CT);
    const int gtid = C.bid * 512 + C.tid, GT = C.G * 512;
    for (int e = gtid; e < MH * DV * DQK; e += GT) {
        const int h = e >> 15, idx = e & 32767; float st = 0.f;
        for (int c0 = 0; c0 < NCH; c0 += 32) {
            float u[32], g[32];
#pragma unroll
            for (int k = 0; k < 32; ++k) { const int unit = h * NCH + c0 + k; u[k] = U[(size_t)unit * (DV * DQK) + idx]; g[k] = GDEC[unit]; }
#pragma unroll
            for (int k = 0; k < 32; ++k) { const int unit = h * NCH + c0 + k; CT[(size_t)unit * (DV * DQK) + idx] = (bf16)(pk2(st, 0.f) & 0xffffu); st = g[k] * st + u[k]; }
        }
    }
    { const int e = (C.G - 1 - C.bid) * 2 + (C.tid >> 8), lsel = C.tid & 255;
      if (lsel == 0 && e < MH * DQK) { const int h = e >> 7, d = e & 127; float st = 0.f;
        for (int c0 = 0; c0 < NCH; c0 += 32) { float u[32], g[32];
#pragma unroll
            for (int k = 0; k < 32; ++k) { const int unit = h * NCH + c0 + k; u[k] = UN[unit * DQK + d]; g[k] = GDEC[unit]; }
#pragma unroll
            for (int k = 0; k < 32; ++k) { const int unit = h * NCH + c0 + k; NST[unit * DQK + d] = st; st = g[k] * st + u[k]; } } } }
}
__device__ __forceinline__ void m3_phase(const Ctx& C, const float* mnorm_g, const float* conv_w, const float* conv_b) {
    const bf16* PROJ = (const bf16*)(C.ws + WS_PROJ);
    const float* LOGF = (const float*)(C.ws + WS_LOGF); const float* IG = (const float*)(C.ws + WS_IG); const float* NST = (const float*)(C.ws + WS_NST);
    const bf16* CT = (const bf16*)(C.ws + WS_CT); bf16* CAT = (bf16*)(C.ws + WS_CAT);
    LAS bf16* Qs = (LAS bf16*)C.lds; LAS bf16* Ks = (LAS bf16*)(C.lds + 17408); LAS bf16* VT = (LAS bf16*)(C.lds + 34816); LAS bf16* P = (LAS bf16*)(C.lds + 71680);
    LAS float* bv = (LAS float*)(C.lds + 80896); LAS float* igv = bv + 64; LAS float* eb = bv + 128; LAS float* den = bv + 192; LAS float* nv = bv + 256;
    LAS float* Hb = (LAS float*)C.lds;
    const int lane = C.lane, wave = C.wave, tid = C.tid, fr = lane & 15, fq = lane >> 4;
    for (int unit = C.bid; unit < MH * NCH; unit += C.G) {
        const int h = unit >> 8, c = unit & 255, row0 = c * CH;
        if (wave == 0) { const float lf = LOGF[h * M + row0 + lane], ig = IG[h * M + row0 + lane]; const float b = incl_scan64(lf, lane);
            bv[lane] = b; igv[lane] = ig; eb[lane] = __expf(b); den[lane] = 0.f; }
        if (wave == 1) { nv[lane] = NST[unit * DQK + lane]; nv[lane + 64] = NST[unit * DQK + 64 + lane]; }
        bf16x8 ctf[4][2]; u32x2 mov[8];
        { const bf16* CTu = CT + (size_t)unit * (DV * DQK);
#pragma unroll
          for (int ks = 0; ks < 4; ++ks)
#pragma unroll
            for (int ci = 0; ci < 2; ++ci) ctf[ks][ci] = *(const bf16x8*)(CTu + ((2 * wave + ci) * 16 + fr) * DQK + 32 * ks + 8 * fq);
#pragma unroll
          for (int i = 0; i < 8; ++i) mov[i] = *(const u32x2*)(PROJ + (size_t)(row0 + 8 * wave + i) * NPROJ + PC_MO + h * DV + 4 * lane); }
        const f32x4 gmn = *(const f32x4*)(mnorm_g + h * DV + 4 * lane);
        { const int tens = tid >> 8, rgrp = (tid >> 4) & 15, cg = tid & 15; float y[4][8];
          conv_rows<4>(PROJ, conv_w, conv_b, tens * 512 + h * DQK + 8 * cg, row0 + 4 * rgrp, tens ? 1.0f : 0.08838834764831845f, y);
          LAS bf16* dst = tens ? Ks : Qs;
#pragma unroll
          for (int r = 0; r < 4; ++r) *(LAS u32x4*)(dst + (4 * rgrp + r) * QKS + 8 * cg) = (u32x4){pk2(y[r][0], y[r][1]), pk2(y[r][2], y[r][3]), pk2(y[r][4], y[r][5]), pk2(y[r][6], y[r][7])}; }
        stage_vt(VT, PROJ, row0, PC_MV + h * DV, wave, lane);
        __syncthreads();
        { const int tr = wave >> 1;
#pragma unroll
          for (int cc = 0; cc < 2; ++cc) { const int tc = 2 * (wave & 1) + cc; const int s = tc * 16 + fr;
            if (tc <= tr) {
                f32x4 acc = (f32x4){0.f, 0.f, 0.f, 0.f};
#pragma unroll
                for (int ks = 0; ks < 4; ++ks) { const bf16x8 a = *(const LAS bf16x8*)(Qs + (tr * 16 + fr) * QKS + 32 * ks + 8 * fq), b = *(const LAS bf16x8*)(Ks + (tc * 16 + fr) * QKS + 32 * ks + 8 * fq);
                    acc = __builtin_amdgcn_mfma_f32_16x16x32_bf16(a, b, acc, 0, 0, 0); }
                const float bs = bv[s], is = igv[s];
#pragma unroll
                for (int j = 0; j < 4; ++j) { const int t = tr * 16 + 4 * fq + j; float p = (s <= t) ? acc[j] * __expf(bv[t] - bs + is) : 0.f;
                    P[t * VTS + s] = (bf16)(pk2(p, 0.f) & 0xffffu);
                    p += __shfl_xor(p, 1); p += __shfl_xor(p, 2); p += __shfl_xor(p, 4); p += __shfl_xor(p, 8);
                    if (fr == 0) unsafeAtomicAdd((float*)&den[t], p); }
            } else {
#pragma unroll
                for (int j = 0; j < 4; ++j) P[(tr * 16 + 4 * fq + j) * VTS + s] = (bf16)0;
            } } }
        { const int t = tid >> 3, part = tid & 7; float s = 0.f;
#pragma unroll
          for (int d = 0; d < 16; ++d) s += bf2f(Qs[t * QKS + 16 * part + d]) * nv[16 * part + d];
          s += __shfl_xor(s, 1); s += __shfl_xor(s, 2); s += __shfl_xor(s, 4);
          if (part == 0) unsafeAtomicAdd((float*)&den[t], eb[t] * s); }
        __syncthreads();
        f32x4 hv[4][2];
        { f32x4 accI[4][2], accP[4][2];
#pragma unroll
          for (int rt = 0; rt < 4; ++rt)
#pragma unroll
            for (int ci = 0; ci < 2; ++ci) { accI[rt][ci] = (f32x4){0.f, 0.f, 0.f, 0.f}; accP[rt][ci] = (f32x4){0.f, 0.f, 0.f, 0.f}; }
#pragma unroll
          for (int ks = 0; ks < 4; ++ks) {
#pragma unroll
            for (int rt = 0; rt < 4; ++rt) { const bf16x8 a = *(const LAS bf16x8*)(Qs + (rt * 16 + fr) * QKS + 32 * ks + 8 * fq);
#pragma unroll
                for (int ci = 0; ci < 2; ++ci) accI[rt][ci] = __builtin_amdgcn_mfma_f32_16x16x32_bf16(a, ctf[ks][ci], accI[rt][ci], 0, 0, 0); } }
#pragma unroll
          for (int ks = 0; ks < 2; ++ks) { bf16x8 b[2];
#pragma unroll
            for (int ci = 0; ci < 2; ++ci) b[ci] = *(const LAS bf16x8*)(VT + ((2 * wave + ci) * 16 + fr) * VTS + 32 * ks + 8 * fq);
#pragma unroll
            for (int rt = 0; rt < 4; ++rt) { const bf16x8 a = *(const LAS bf16x8*)(P + (rt * 16 + fr) * VTS + 32 * ks + 8 * fq);
#pragma unroll
                for (int ci = 0; ci < 2; ++ci) accP[rt][ci] = __builtin_amdgcn_mfma_f32_16x16x32_bf16(a, b[ci], accP[rt][ci], 0, 0, 0); } }
#pragma unroll
          for (int rt = 0; rt < 4; ++rt)
#pragma unroll
            for (int j = 0; j < 4; ++j) { const int t = rt * 16 + 4 * fq + j; const float e = eb[t], dn = 1.0f / fmaxf(fabsf(den[t]), 1.0f);
#pragma unroll
                for (int ci = 0; ci < 2; ++ci) hv[rt][ci][j] = (e * accI[rt][ci][j] + accP[rt][ci][j]) * dn; } }
        __syncthreads();
#pragma unroll
        for (int rt = 0; rt < 4; ++rt)
#pragma unroll
            for (int ci = 0; ci < 2; ++ci)
#pragma unroll
                for (int j = 0; j < 4; ++j) Hb[(rt * 16 + 4 * fq + j) * 260 + (2 * wave + ci) * 16 + fr] = hv[rt][ci][j];
        __syncthreads();
#pragma unroll
        for (int i = 0; i < 8; ++i) { const int t = 8 * wave + i;
            const f32x4 v = *(const LAS f32x4*)(Hb + t * 260 + 4 * lane);
            const float ss = wave_sum((v.x * v.x + v.y * v.y) + (v.z * v.z + v.w * v.w));
            const float rs = 1.0f / sqrtf(ss * (1.0f / DV) + EPS);
            const f32x4 g = gmn; const u32x2 mo = mov[i];
            const float o0 = v.x * rs * g.x * sigmoidf_(bf2f(mo.x & 0xffffu)), o1 = v.y * rs * g.y * sigmoidf_(bf2f(mo.x >> 16));
            const float o2 = v.z * rs * g.z * sigmoidf_(bf2f(mo.y & 0xffffu)), o3 = v.w * rs * g.w * sigmoidf_(bf2f(mo.y >> 16));
            u32x2 w; w.x = pk2(o0, o1); w.y = pk2(o2, o3);
            *(u32x2*)(CAT + (size_t)(row0 + t) * DM + h * DV + 4 * lane) = w; }
        __syncthreads();
    }
}
}

__device__ __forceinline__ void attn_combine(const Ctx& C, const Args& A) {
    const bf16* AO = (const bf16*)(C.ws + WS_ATTO); bf16* CAT = (bf16*)(C.ws + WS_CAT);
    const int lane = C.lane;
    const float l1 = wave_sum(A.in[8][lane] * A.in[9][lane]), l2 = wave_sum(A.in[10][lane] * A.in[11][lane]);
    const float lam = expf(l1) - expf(l2) + LAM_INIT;
    const int h = lane >> 3, part = lane & 7;
    float g[16];
#pragma unroll
    for (int q = 0; q < 4; ++q) { const f32x4 t = *(const f32x4*)(A.in[12] + 16 * part + 4 * q); g[4 * q] = t.x * (1.0f - LAM_INIT); g[4 * q + 1] = t.y * (1.0f - LAM_INIT); g[4 * q + 2] = t.z * (1.0f - LAM_INIT); g[4 * q + 3] = t.w * (1.0f - LAM_INIT); }
    const int gw = C.bid * 8 + C.wave, NGW = C.G * 8;
    for (int t0 = gw; t0 < M; t0 += 2 * NGW) {
        u32x4 a[2][2], b[2][2];
#pragma unroll
        for (int rr = 0; rr < 2; ++rr) { const int t = t0 + rr * NGW; if (t < M) { const bf16* p = AO + (size_t)t * DM + h * 256 + 16 * part;
            a[rr][0] = *(const u32x4*)p; a[rr][1] = *(const u32x4*)(p + 8); b[rr][0] = *(const u32x4*)(p + 128); b[rr][1] = *(const u32x4*)(p + 136); } }
#pragma unroll
        for (int rr = 0; rr < 2; ++rr) { const int t = t0 + rr * NGW; if (t < M) {
            float d[16]; float ss = 0.f;
#pragma unroll
            for (int q = 0; q < 2; ++q)
#pragma unroll
                for (int k = 0; k < 4; ++k) { const unsigned wa = a[rr][q][k], wb = b[rr][q][k];
                    const float d0 = bf2f(wa & 0xffffu) - lam * bf2f(wb & 0xffffu), d1 = bf2f(wa >> 16) - lam * bf2f(wb >> 16);
                    d[8 * q + 2 * k] = d0; d[8 * q + 2 * k + 1] = d1; ss += d0 * d0 + d1 * d1; }
            ss += __shfl_xor(ss, 1); ss += __shfl_xor(ss, 2); ss += __shfl_xor(ss, 4);
            const float rs = 1.0f / sqrtf(ss * (1.0f / 128.0f) + EPS);
            u32x4 o0, o1;
#pragma unroll
            for (int k = 0; k < 4; ++k) { o0[k] = pk2(d[2 * k] * rs * g[2 * k], d[2 * k + 1] * rs * g[2 * k + 1]); o1[k] = pk2(d[8 + 2 * k] * rs * g[8 + 2 * k], d[9 + 2 * k] * rs * g[9 + 2 * k]); }
            bf16* q = CAT + (size_t)t * DM + 1024 + h * 128 + 16 * part; *(u32x4*)q = o0; *(u32x4*)(q + 8) = o1; } }
    }
}

#define XB_TMO      128
#define XB_XCNT(j)  (256  + 64 * (j))
#define XB_XSUB(j)  (1280 + 64 * (j))
#define XB_XGEN(j)  (2304 + 64 * (j))
#define XB_TOP      3328
#define XB_TOPGEN   3392
#define XCD_BAR_WORDS 3456
#define XB_SPIN_CAP (1u << 18)

__device__ __forceinline__ unsigned xb_ld(unsigned* p)              { return __hip_atomic_load(p, __ATOMIC_RELAXED, __HIP_MEMORY_SCOPE_AGENT); }
__device__ __forceinline__ unsigned xb_add(unsigned* p, unsigned v) { return __hip_atomic_fetch_add(p, v, __ATOMIC_RELAXED, __HIP_MEMORY_SCOPE_AGENT); }
__device__ __forceinline__ unsigned xb_xcc_id() { return (unsigned)__builtin_amdgcn_s_getreg((3 << 11) | 20) & 0xFu; }
#define XB_SPIN(cond, bar) do { unsigned _sp = 0; while (cond) { __builtin_amdgcn_s_sleep(1); \
    if ((++_sp & 255u) == 0u) { if (xb_ld(&(bar)[XB_TMO])) break; if (_sp > XB_SPIN_CAP) { atomicAdd(&(bar)[XB_TMO], 1u); break; } } } } while (0)

struct XcdBarrier {
    unsigned* bar; unsigned x;
    volatile LAS unsigned* st;
};

__device__ __forceinline__ XcdBarrier xcd_barrier_post(unsigned* bar, volatile LAS unsigned* st) {
    XcdBarrier b; b.bar = bar; b.x = xb_xcc_id(); b.st = st;
    if (threadIdx.x == 0) (void)xb_add(&bar[XB_XCNT(b.x)], 1u);
    return b;
}
__device__ __forceinline__ void xcd_barrier_complete(unsigned* bar, unsigned x, unsigned& nloc, unsigned& nx) {
    const unsigned G = gridDim.x * gridDim.y * gridDim.z;
    unsigned sum, cnt, mine, sp = 0u;
    for (;;) {
        sum = 0u; cnt = 0u; mine = 0u;
#pragma unroll
        for (unsigned j = 0; j < 16; ++j) { const unsigned c = xb_ld(&bar[XB_XCNT(j)]); sum += c; cnt += (c > 0u) ? 1u : 0u; mine = (j == x) ? c : mine; }
        if (sum == G) break;
        __builtin_amdgcn_s_sleep(1);
        if ((++sp & 255u) == 0u) { if (xb_ld(&bar[XB_TMO])) break; if (sp > XB_SPIN_CAP) { atomicAdd(&bar[XB_TMO], 1u); break; } }
    }
    nloc = mine > 0u ? mine : 1u; nx = cnt > 0u ? cnt : 1u;
}

__device__ __forceinline__ void xcd_barrier(const XcdBarrier& b) {
    asm volatile("s_waitcnt vmcnt(0)" ::: "memory");
    __syncthreads();
    if (threadIdx.x == 0) {
        unsigned* bar = b.bar;
        __builtin_amdgcn_s_waitcnt(0);
        unsigned nloc = b.st[0], nx = b.st[1];
        if (nloc == 0u) { xcd_barrier_complete(bar, b.x, nloc, nx); b.st[0] = nloc; b.st[1] = nx; }
        const unsigned old = xb_add(&bar[XB_XSUB(b.x)], 1u);
        const unsigned gen = old / nloc;
        if (old + 1u == (gen + 1u) * nloc) {
            __builtin_amdgcn_fence(__ATOMIC_RELEASE, "agent");
            asm volatile("s_waitcnt vmcnt(0)" ::: "memory");
            const unsigned og = xb_add(&bar[XB_TOP], 1u);
            const unsigned tg = og / nx;
            if (og + 1u == (tg + 1u) * nx) xb_add(&bar[XB_TOPGEN], 1u);
            else XB_SPIN(xb_ld(&bar[XB_TOPGEN]) == tg, bar);
            __builtin_amdgcn_fence(__ATOMIC_ACQUIRE, "agent");
            xb_add(&bar[XB_XGEN(b.x)], 1u);
            asm volatile("s_waitcnt vmcnt(0)" ::: "memory");
        } else {
            XB_SPIN(xb_ld(&bar[XB_XGEN(b.x)]) == gen, bar);
            __builtin_amdgcn_fence(__ATOMIC_ACQUIRE, "agent");
            asm volatile("s_waitcnt vmcnt(0)" ::: "memory");
        }
    }
    __syncthreads();
}

__global__ void __launch_bounds__(512, 2) fwd_megakernel(Args args) {
    __builtin_assume(__builtin_amdgcn_workitem_id_y() == 0); __builtin_assume(__builtin_amdgcn_workitem_id_z() == 0);
    extern __shared__ __attribute__((aligned(16))) unsigned char lds[];
    cg::grid_group grid = cg::this_grid();
#define MKCTX() Ctx C; { int t_ = threadIdx.x; asm volatile("" : "+v"(t_)); C.lds = (LAS unsigned char*)lds; C.tid = t_; C.lane = t_ & 63; C.wave = __builtin_amdgcn_readfirstlane(t_ >> 6); C.G = gridDim.x; C.bid = blockIdx.x; C.ws = args.ws; }
    unsigned char* const wsb = args.ws; const int G_ = gridDim.x, bid_ = blockIdx.x;
    const int lo = args.ph_lo, hi = args.ph_hi;
    volatile LAS unsigned* bst = (volatile LAS unsigned*)((LAS unsigned char*)lds + 147392);
    if (threadIdx.x < 16) bst[threadIdx.x] = 0u;
    __syncthreads();
    const XcdBarrier bar = xcd_barrier_post((unsigned*)(args.ws + WS_BAR), bst);
    if (hi > 1000) grid.sync();
#define IN(k) (lo <= (k) && (k) < hi)
#define SEAM(k) do { if (IN(k) && IN((k) + 1)) xcd_barrier(bar); } while (0)
    const float* x = args.in[0];
    bf16* XN = (bf16*)(wsb + WS_XN); bf16* PROJ = (bf16*)(wsb + WS_PROJ); bf16* CAT = (bf16*)(wsb + WS_CAT); bf16* ACT = (bf16*)(wsb + WS_ACT);

    if (IN(0)) { MKCTX();
        LAS float* wg = (LAS float*)C.lds;
        for (int i = C.tid; i < 8 * DM; i += 512) { const int k = i >> 3, q = i & 7; wg[q * DM + k] = args.in[2][(size_t)k * 6152 + 3072 + q]; }
        __syncthreads();
        rows_pass<0>(C, x, args.in[1], XN, nullptr, wg, args.in[5], args.in[6]);
        { float* TAB = (float*)(C.ws + WS_TAB);
          for (int i = C.bid * 512 + C.tid; i < M * 32; i += C.G * 512) { const int t = i >> 5, d = i & 31; const float ang = (float)t * args.inv[d];
              double rev = (double)ang * 0.15915494309189535; rev -= rint(rev); const float fr = (float)rev; TAB[2 * i] = __builtin_amdgcn_cosf(fr); TAB[2 * i + 1] = __builtin_amdgcn_sinf(fr); } }
        __syncthreads();
        p0_weights<0>(C, args.in[2], args.in[13], args.in[15], args.in[16], args.in[17]);
        __syncthreads();
    }
    SEAM(0);
    if (IN(1)) { MKCTX();
        pg8::Gemm g{XN, (const bf16*)(C.ws + WS_WIN), M, NPROJ, DM}; pg8::StaticOrder S; S.init(M, NPROJ, C.G, C.bid);
        pg8::EpiProj E{PROJ, NPROJ, (const float*)(C.ws + WS_TAB), 0.125f * 1.4426950408889634f};
        const bool side_last = ((C.bid >> 3) & 1) != 0;
        if (!side_last) { p0_weights<1>(C, args.in[2], args.in[13], args.in[15], args.in[16], args.in[17]); __syncthreads(); }
        pg8::gemm_phase<pg8::EpiProj, pg8::StaticOrder, PG8_ALIGN, PG8_SP2>(C.lds, g, S, E);
        if (side_last) { __syncthreads(); p0_weights<1>(C, args.in[2], args.in[13], args.in[15], args.in[16], args.in[17]); __syncthreads(); }
    }
    SEAM(1);
    if (IN(2)) {
        const attn128::AttnTensors AT{(const attn128::bf16*)PROJ, (attn128::bf16*)(wsb + WS_ATTO)};
        const bool m1_last = ((bid_ >> 3) & 1) != 0; const int lateq = 2 + ((bid_ >> 4) & 1);
        if (lateq == 2) { { MKCTX(); p0_weights<2>(C, args.in[2], args.in[13], args.in[15], args.in[16], args.in[17]); } __syncthreads(); }
        if (!m1_last) { { MKCTX(); ml::m1_phase(C, args.out, args.in[3], args.in[4]); } __syncthreads(); }
        attn128::attn_phase<8>((char*)lds, AT, G_, bid_);
        if (m1_last) { __syncthreads(); { MKCTX(); ml::m1_phase(C, args.out, args.in[3], args.in[4]); } }
        if (lateq == 3) { __syncthreads(); { MKCTX(); p0_weights<2>(C, args.in[2], args.in[13], args.in[15], args.in[16], args.in[17]); } __syncthreads(); }
    }
    SEAM(2);
    if (IN(3)) { MKCTX(); ml::m2_scan(C, args.out); }
    SEAM(3);
    if (IN(4)) { { MKCTX(); ml::m3_phase(C, args.in[7], args.in[3], args.in[4]); } { MKCTX(); attn_combine(C, args); } }
    SEAM(4);
    if (IN(5)) { MKCTX();
        pg8::Gemm g{CAT, (const bf16*)(C.ws + WS_WOUT), M, DM, DM}; pg8::StaticOrder S; S.init(M, DM, C.G, C.bid);
        pg8::EpiBf16<0> E{(bf16*)(C.ws + WS_CT), DM, nullptr, 0, 0, 1.f};
        pg8::gemm_phase<pg8::EpiBf16<0>, pg8::StaticOrder, PG8_ALIGN, PG8_SP2>(C.lds, g, S, E);
    }
    SEAM(5);
    if (IN(6)) { MKCTX(); rows_pass<1>(C, x, args.in[14], XN, nullptr, nullptr, nullptr, nullptr, (const bf16*)(C.ws + WS_CT), nullptr); }
    SEAM(6);
    if (IN(7)) { MKCTX();
        pg8::Gemm g{XN, (const bf16*)(C.ws + WS_WGU), M, NGU, DM}; pg8::StaticOrder S; S.init(M, NGU, C.G, C.bid);
        pg8::EpiSwiGLU E{ACT, FF};
        const bool side_last = ((C.bid >> 3) & 1) != 0;
        if (!side_last) { p0_weights<3>(C, args.in[2], args.in[13], args.in[15], args.in[16], args.in[17]); __syncthreads(); }
        pg8::gemm_phase<pg8::EpiSwiGLU, pg8::StaticOrder, PG8_ALIGN, PG8_SP2>(C.lds, g, S, E);
        if (side_last) { __syncthreads(); p0_weights<3>(C, args.in[2], args.in[13], args.in[15], args.in[16], args.in[17]); __syncthreads(); }
    }
    SEAM(7);
    if (IN(8)) { MKCTX();
        pg8::Gemm g{ACT, (const bf16*)(C.ws + WS_WD), M, DM, FF}; pg8::StaticOrder S; S.init(M, DM, C.G, C.bid);
        pg8::EpiBf16<0> E{CAT, DM, nullptr, 0, 0, 1.f};
        pg8::gemm_phase<pg8::EpiBf16<0>, pg8::StaticOrder, PG8_ALIGN, PG8_SP2>(C.lds, g, S, E);
    }
    SEAM(8);
    if (IN(9)) { MKCTX(); rows_pass<2>(C, x, args.in[18], nullptr, args.out, nullptr, nullptr, nullptr, (const bf16*)(C.ws + WS_CT), CAT); }
#undef IN
#undef SEAM
}

#ifndef MK_N_LAUNCHES
#define MK_N_LAUNCHES 1
#endif
extern "C" void kernel_launch(void* const* d_in, const int* in_sizes, int n_in, void* d_out, int out_size, void* d_ws, size_t ws_size, hipStream_t stream) {
    static int grid = 0;
    if (grid == 0) {
        if (n_in != 19 || in_sizes[0] != M * DM || out_size != M * DM || ws_size < WS_END) { fprintf(stderr, "kernel_launch: unexpected shapes: n_in %d in0 %d out %d ws %zu (need %zu); nothing launched\n", n_in, n_in > 0 ? in_sizes[0] : -1, out_size, ws_size, (size_t)WS_END); grid = -1; return; }
        int dev = 0, cus = 0, per_cu = 0;
        if (hipGetDevice(&dev) != hipSuccess || hipDeviceGetAttribute(&cus, hipDeviceAttributeMultiprocessorCount, dev) != hipSuccess) { grid = -1; return; }
        if (hipFuncSetAttribute((const void*)fwd_megakernel, hipFuncAttributeMaxDynamicSharedMemorySize, LDS_BYTES) != hipSuccess) { fprintf(stderr, "kernel_launch: hipFuncSetAttribute failed\n"); grid = -1; return; }
        if (hipOccupancyMaxActiveBlocksPerMultiprocessor(&per_cu, (const void*)fwd_megakernel, 512, LDS_BYTES) != hipSuccess || per_cu < 1) { fprintf(stderr, "kernel_launch: occupancy query says %d\n", per_cu); per_cu = 1; }
        (void)hipGetLastError();
        grid = cus * per_cu;
        fprintf(stderr, "kernel_launch: grid %d (cus %d x %d), ws %zu MiB\n", grid, cus, per_cu, ws_size >> 20);
    }
    if (grid < 0) return;
    Args a{};
    for (int i = 0; i < 19; ++i) a.in[i] = (const float*)d_in[i];
    a.out = (float*)d_out; a.ws = (unsigned char*)d_ws;
    for (int d = 0; d < 32; ++d) a.inv[d] = (float)pow(10000.0, -(double)d / 32.0);
    if (hipMemsetAsync((char*)d_ws + WS_BAR, 0, 16384, stream) != hipSuccess) { fprintf(stderr, "kernel_launch: memset of the barrier words failed\n"); return; }
    if (MK_N_LAUNCHES == 1) {
        a.ph_lo = 0; a.ph_hi = 10;
        void* kargs[] = {&a};
        hipError_t e = hipLaunchCooperativeKernel((const void*)fwd_megakernel, dim3(grid), dim3(512), kargs, LDS_BYTES, stream);
        if (e != hipSuccess) fprintf(stderr, "cooperative launch failed: %s (grid %d)\n", hipGetErrorString(e), grid);
    } else {
        for (int p = 0; p < 10; ++p) { a.ph_lo = p; a.ph_hi = p + 1; hipLaunchKernelGGL(fwd_megakernel, dim3(grid), dim3(512), LDS_BYTES, stream, a); }
    }
}
```
